# Optimizing an MI355X kernel written in HIP

```python
import jax, jax.numpy as jnp
from jax import lax
import numpy as np

D_MODEL = 4096
BATCH = 2
SEQ = 8192
DEPTH = 1

MIX_WIDTH = D_MODEL
FOURIER_WIDTH = D_MODEL // 2
FOURIER_GROUPS = 8
FOURIER_GROUP_DIM = FOURIER_WIDTH // FOURIER_GROUPS
MLA_HEADS = 16
MLA_NOPE_DIM = 128
MLA_ROPE_DIM = 64
MLA_V_DIM = 128
MLA_WIDTH = MLA_HEADS * MLA_V_DIM
Q_LORA_RANK = 1024
KV_LORA_RANK = 512
IN_PROJ_WIDTH = FOURIER_WIDTH + Q_LORA_RANK + KV_LORA_RANK + MLA_ROPE_DIM
ROPE_THETA = 10000.0
Q_BLOCK = 128
MEM_TOKENS = 256
XATTN_HEADS = 4
XATTN_HEAD_DIM = D_MODEL // XATTN_HEADS
D_FF = 4 * D_MODEL
NORM_EPS = 1e-6

kernel_name = "hybrid_fnet_mla_memxattn_encoder"


def rms_norm(x, g):
    xf = x.astype(jnp.float32)
    y = xf * lax.rsqrt(jnp.mean(xf * xf, axis=-1, keepdims=True) + NORM_EPS)
    return (y * g.astype(jnp.float32)).astype(x.dtype)


def apply_rope(t, cos, sin):
    half = MLA_ROPE_DIM // 2
    tf = t.astype(jnp.float32)
    t1, t2 = tf[..., :half], tf[..., half:]
    return jnp.concatenate([t1 * cos - t2 * sin, t1 * sin + t2 * cos], axis=-1).astype(t.dtype)


def fourier_mix(z_f, w_fourier):
    b, s, _ = z_f.shape
    zg = z_f.reshape(b, s, FOURIER_GROUPS, FOURIER_GROUP_DIM).astype(jnp.float32)
    zg = jnp.transpose(zg, (0, 2, 1, 3))
    f = jnp.fft.fft2(zg, axes=(-2, -1), norm="ortho").real
    y = jnp.einsum('bgsc,gcd->bsgd', f.astype(z_f.dtype), w_fourier)
    return y.reshape(b, s, FOURIER_WIDTH)


def mla_attention(c_q, c_kv, k_rope, g_q_lora, g_kv_lora, w_uq, w_ukv, cos, sin):
    b, s, _ = c_q.shape
    q = jnp.einsum('bsr,rhd->bshd', rms_norm(c_q, g_q_lora), w_uq)
    q_nope = q[..., :MLA_NOPE_DIM]
    q_rope = apply_rope(q[..., MLA_NOPE_DIM:], cos[:, :, None, :], sin[:, :, None, :])
    kv = jnp.einsum('bsr,rhd->bshd', rms_norm(c_kv, g_kv_lora), w_ukv)
    k_nope = kv[..., :MLA_NOPE_DIM]
    v = kv[..., MLA_NOPE_DIM:]
    k_r = apply_rope(k_rope, cos, sin)
    scale = (MLA_NOPE_DIM + MLA_ROPE_DIM) ** -0.5
    nblk = s // Q_BLOCK
    qn = q_nope.reshape(b, nblk, Q_BLOCK, MLA_HEADS, MLA_NOPE_DIM).swapaxes(0, 1)
    qr = q_rope.reshape(b, nblk, Q_BLOCK, MLA_HEADS, MLA_ROPE_DIM).swapaxes(0, 1)

    def query_block(args):
        qn_b, qr_b = args
        sc = (jnp.einsum('bqhd,bkhd->bhqk', qn_b, k_nope, preferred_element_type=jnp.float32)
              + jnp.einsum('bqhr,bkr->bhqk', qr_b, k_r, preferred_element_type=jnp.float32)) * scale
        p = jax.nn.softmax(sc, axis=-1).astype(v.dtype)
        return jnp.einsum('bhqk,bkhd->bqhd', p, v)

    o = lax.map(query_block, (qn, qr))
    return o.swapaxes(0, 1).reshape(b, s, MLA_WIDTH)


def memory_cross_attention(hn, mem_n, w_xq, w_xk, w_xv, w_xo):
    q = jnp.einsum('bsd,dhe->bshe', hn, w_xq)
    k = jnp.einsum('bmd,dhe->bmhe', mem_n, w_xk)
    v = jnp.einsum('bmd,dhe->bmhe', mem_n, w_xv)
    sc = jnp.einsum('bshe,bmhe->bhsm', q, k, preferred_element_type=jnp.float32) * (XATTN_HEAD_DIM ** -0.5)
    p = jax.nn.softmax(sc, axis=-1).astype(v.dtype)
    o = jnp.einsum('bhsm,bmhe->bshe', p, v)
    return jnp.einsum('bshe,hed->bsd', o, w_xo)


def setup_inputs(seed: int = 0) -> dict:
    key = jax.random.key(seed)
    ks = jax.random.split(key, 24)
    f32 = jnp.float32

    def nrm(k, shape, fan_in):
        return jax.random.normal(k, shape, f32) * (fan_in ** -0.5)

    def gain(k, shape):
        return 1.0 + 0.02 * jax.random.normal(k, shape, f32)

    L = DEPTH
    x = jax.random.normal(ks[0], (BATCH, SEQ, D_MODEL), f32)
    mem = jax.random.normal(ks[1], (BATCH, MEM_TOKENS, D_MODEL), f32)
    offsets = jax.random.randint(ks[2], (BATCH, 1), 0, SEQ, dtype=jnp.int32)
    positions = (jnp.arange(SEQ, dtype=jnp.int32)[None, :] + offsets).astype(jnp.int32)
    return {
        "x": x,
        "mem": mem,
        "positions": positions,
        "g_mix": gain(ks[3], (L, D_MODEL)),
        "w_in": nrm(ks[4], (L, D_MODEL, IN_PROJ_WIDTH), D_MODEL),
        "w_fourier": nrm(ks[5], (L, FOURIER_GROUPS, FOURIER_GROUP_DIM, FOURIER_GROUP_DIM), FOURIER_GROUP_DIM),
        "g_q_lora": gain(ks[6], (L, Q_LORA_RANK)),
        "w_uq": nrm(ks[7], (L, Q_LORA_RANK, MLA_HEADS, MLA_NOPE_DIM + MLA_ROPE_DIM), Q_LORA_RANK),
        "g_kv_lora": gain(ks[8], (L, KV_LORA_RANK)),
        "w_ukv": nrm(ks[9], (L, KV_LORA_RANK, MLA_HEADS, MLA_NOPE_DIM + MLA_V_DIM), KV_LORA_RANK),
        "g_fourier_out": gain(ks[10], (L, FOURIER_WIDTH)),
        "g_mla_out": gain(ks[11], (L, MLA_WIDTH)),
        "w_out": nrm(ks[12], (L, MIX_WIDTH, D_MODEL), MIX_WIDTH),
        "g_xattn": gain(ks[13], (L, D_MODEL)),
        "g_mem": gain(ks[14], (L, D_MODEL)),
        "w_xq": nrm(ks[15], (L, D_MODEL, XATTN_HEADS, XATTN_HEAD_DIM), D_MODEL),
        "w_xk": nrm(ks[16], (L, D_MODEL, XATTN_HEADS, XATTN_HEAD_DIM), D_MODEL),
        "w_xv": nrm(ks[17], (L, D_MODEL, XATTN_HEADS, XATTN_HEAD_DIM), D_MODEL),
        "w_xo": nrm(ks[18], (L, XATTN_HEADS, XATTN_HEAD_DIM, D_MODEL), D_MODEL),
        "g_mlp": gain(ks[19], (L, D_MODEL)),
        "w_ff1": nrm(ks[20], (L, D_MODEL, D_FF), D_MODEL),
        "w_ff2": nrm(ks[21], (L, D_FF, D_MODEL), D_FF),
        "g_final": gain(ks[22], (D_MODEL,)),
    }


def reference(x, mem, positions, g_mix, w_in, w_fourier, g_q_lora, w_uq, g_kv_lora, w_ukv,
              g_fourier_out, g_mla_out, w_out, g_xattn, g_mem, w_xq, w_xk, w_xv, w_xo,
              g_mlp, w_ff1, w_ff2, g_final):
    half = MLA_ROPE_DIM // 2
    inv_freq = ROPE_THETA ** (-jnp.arange(half, dtype=jnp.float32) / half)
    ang = positions.astype(jnp.float32)[..., None] * inv_freq
    cos, sin = jnp.cos(ang), jnp.sin(ang)
    split_pts = [FOURIER_WIDTH, FOURIER_WIDTH + Q_LORA_RANK, FOURIER_WIDTH + Q_LORA_RANK + KV_LORA_RANK]

    h = x
    for layer in range(DEPTH):
        u = rms_norm(h, g_mix[layer])
        z = jnp.einsum('bsd,de->bse', u, w_in[layer])
        z_f, c_q, c_kv, k_rope = jnp.split(z, split_pts, axis=-1)
        y_f = rms_norm(fourier_mix(z_f, w_fourier[layer]), g_fourier_out[layer])
        y_a = rms_norm(mla_attention(c_q, c_kv, k_rope, g_q_lora[layer], g_kv_lora[layer],
                                     w_uq[layer], w_ukv[layer], cos, sin), g_mla_out[layer])
        y = jnp.concatenate([y_f, y_a], axis=-1)
        h = h + jnp.einsum('bse,ed->bsd', y, w_out[layer])
        mem_n = rms_norm(mem, g_mem[layer])
        h = h + memory_cross_attention(rms_norm(h, g_xattn[layer]), mem_n,
                                       w_xq[layer], w_xk[layer], w_xv[layer], w_xo[layer])
        hn = rms_norm(h, g_mlp[layer])
        a = jnp.square(jax.nn.relu(jnp.einsum('bsd,df->bsf', hn, w_ff1[layer])))
        h = h + jnp.einsum('bsf,fd->bsd', a, w_ff2[layer])
    return rms_norm(h, g_final)
```

```cpp
#include <hip/hip_runtime.h>
#include <cstdio>
#include <cstdint>

#ifndef MK_PER_PHASE
#define MK_PER_PHASE 0
#endif

#define LAS __attribute__((address_space(3)))
#define GAS __attribute__((address_space(1)))
typedef unsigned short bf16_t;
typedef short bf16x8 __attribute__((ext_vector_type(8)));
typedef short s16x4 __attribute__((ext_vector_type(4)));
typedef float f32x2 __attribute__((ext_vector_type(2)));
typedef float f32x4 __attribute__((ext_vector_type(4)));
typedef float f32x16 __attribute__((ext_vector_type(16)));
typedef unsigned u32x2 __attribute__((ext_vector_type(2)));
typedef unsigned u32x4 __attribute__((ext_vector_type(4)));

constexpr int DM = 4096, NB = 2, SEQ = 8192, NTOK = NB * SEQ;
constexpr int FW = 2048, FG = 8, FC = 256;
constexpr int NH = 16, DNOPE = 128, DROPE = 64, DV = 128, DQK = 192;
constexpr int QR = 1024, KVR = 512, INW = 3648, INWP = 3840;
constexpr int MEMT = 256, XH = 4, XHD = 1024;
constexpr int DFF = 16384;
constexpr float NORM_EPS = 1e-6f;
constexpr int NWAVES = 8, NTHR = 512;

constexpr size_t MiB = 1ull << 20;
constexpr size_t WS_CTL = 0, CTL_ZERO_BYTES = 64 * 1024;
constexpr size_t WS_ROPEC = 1 * MiB, WS_ROPES = 3 * MiB, WS_Y4096 = 5 * MiB, WS_MEMN = 6 * MiB, WS_KX = 10 * MiB, WS_VX = 14 * MiB;
constexpr size_t WS_WUQT = 18 * MiB, WS_WUKVT = 24 * MiB, WS_MGT = 28 * MiB, WS_MT = 30 * MiB, WS_NVT = 46 * MiB;
constexpr size_t WS_XN = 64 * MiB, WS_TT = 64 * MiB;
constexpr size_t WS_CS = 192 * MiB, WS_SS = 256 * MiB, WS_Y = 192 * MiB, WS_A = 192 * MiB;
constexpr size_t WS_ZF = 320 * MiB, WS_CQ = 384 * MiB, WS_CKV = 416 * MiB, WS_KROPE = 432 * MiB, WS_CT = 320 * MiB, WS_DT = 384 * MiB;
constexpr size_t WS_WINT = 448 * MiB, WS_WXKT = 480 * MiB, WS_WXVT = 512 * MiB, WS_Q = 448 * MiB, WS_K = 544 * MiB, WS_V = 640 * MiB;
constexpr size_t WS_YA = 704 * MiB, WS_SC = 704 * MiB, WS_WOUTT = 768 * MiB, WS_P = 800 * MiB, WS_WXQ = 832 * MiB, WS_WXOT = 864 * MiB;
constexpr size_t WS_W1T = 704 * MiB, WS_W2T = 832 * MiB, WS_END = 960 * MiB;
constexpr int CW_BAR = 4096;

constexpr int RING_BYTES = 131072;
constexpr int MISC_OFF = RING_BYTES;
constexpr int LDS_BYTES = RING_BYTES + 1024;

typedef __bf16 bf16x2_t __attribute__((ext_vector_type(2)));
__device__ __forceinline__ unsigned cvt_pk_bf16(float lo, float hi) { const f32x2 v = {lo, hi}; const bf16x2_t r = __builtin_convertvector(v, bf16x2_t); return __builtin_bit_cast(unsigned, r); }
__device__ __forceinline__ float bf2f(unsigned short b) { return __uint_as_float(((unsigned)b) << 16); }
__device__ __forceinline__ float bflo(unsigned w) { return __uint_as_float(w << 16); }
__device__ __forceinline__ float bfhi(unsigned w) { return __uint_as_float(w & 0xffff0000u); }
__device__ __forceinline__ float wave_sum(float v) {
#pragma unroll
    for (int o = 1; o < 64; o <<= 1) v += __shfl_xor(v, o);
    return v;
}
__device__ __forceinline__ float wave_max(float v) {
#pragma unroll
    for (int o = 1; o < 64; o <<= 1) v = fmaxf(v, __shfl_xor(v, o));
    return v;
}
#define LDS_WAIT() asm volatile("s_waitcnt lgkmcnt(0)" ::: "memory")
#define VM_WAIT() asm volatile("s_waitcnt vmcnt(0)" ::: "memory")

#define XB_TMO      128
#define XB_XCNT(j)  (256  + 64 * (j))
#define XB_XSUB(j)  (1280 + 64 * (j))
#define XB_XGEN(j)  (2304 + 64 * (j))
#define XB_TOP      3328
#define XB_TOPGEN   3392
#define XCD_BAR_WORDS 3456
#define XB_SPIN_CAP (1u << 18)
__device__ __forceinline__ unsigned xb_ld(unsigned* p)              { return __hip_atomic_load(p, __ATOMIC_RELAXED, __HIP_MEMORY_SCOPE_AGENT); }
__device__ __forceinline__ unsigned xb_add(unsigned* p, unsigned v) { return __hip_atomic_fetch_add(p, v, __ATOMIC_RELAXED, __HIP_MEMORY_SCOPE_AGENT); }
__device__ __forceinline__ unsigned xb_xcc_id() { return (unsigned)__builtin_amdgcn_s_getreg((3 << 11) | 20) & 0xFu; }
#define XB_SPIN(cond, bar) do { unsigned _sp = 0; while (cond) { __builtin_amdgcn_s_sleep(1); \
    if ((++_sp & 255u) == 0u) { if (xb_ld(&(bar)[XB_TMO])) break; if (_sp > XB_SPIN_CAP) { atomicAdd(&(bar)[XB_TMO], 1u); break; } } } } while (0)
struct XcdBarrier { unsigned* bar; unsigned x; volatile LAS unsigned* st; };
__device__ __forceinline__ XcdBarrier xcd_barrier_post(unsigned* bar, volatile LAS unsigned* st) {
    XcdBarrier b; b.bar = bar; b.x = xb_xcc_id(); b.st = st;
    if (threadIdx.x == 0) (void)xb_add(&bar[XB_XCNT(b.x)], 1u);
    return b;
}
__device__ __forceinline__ void xcd_barrier_complete(unsigned* bar, unsigned x, unsigned& nloc, unsigned& nx) {
    const unsigned G = gridDim.x * gridDim.y * gridDim.z;
    unsigned sum, cnt, mine, sp = 0u;
    for (;;) {
        sum = 0u; cnt = 0u; mine = 0u;
#pragma unroll
        for (unsigned j = 0; j < 16; ++j) { const unsigned c = xb_ld(&bar[XB_XCNT(j)]); sum += c; cnt += (c > 0u) ? 1u : 0u; mine = (j == x) ? c : mine; }
        if (sum == G) break;
        __builtin_amdgcn_s_sleep(1);
        if ((++sp & 255u) == 0u) { if (xb_ld(&bar[XB_TMO])) break; if (sp > XB_SPIN_CAP) { atomicAdd(&bar[XB_TMO], 1u); break; } }
    }
    nloc = mine > 0u ? mine : 1u; nx = cnt > 0u ? cnt : 1u;
}
__device__ __forceinline__ void xcd_barrier(const XcdBarrier& b) {
    asm volatile("s_waitcnt vmcnt(0)" ::: "memory");
    __syncthreads();
    if (threadIdx.x == 0) {
        unsigned* bar = b.bar;
        __builtin_amdgcn_s_waitcnt(0);
        unsigned nloc = b.st[0], nx = b.st[1];
        if (nloc == 0u) { xcd_barrier_complete(bar, b.x, nloc, nx); b.st[0] = nloc; b.st[1] = nx; }
        const unsigned old = xb_add(&bar[XB_XSUB(b.x)], 1u);
        const unsigned gen = old / nloc;
        if (old + 1u == (gen + 1u) * nloc) {
            __builtin_amdgcn_fence(__ATOMIC_RELEASE, "agent");
            asm volatile("s_waitcnt vmcnt(0)" ::: "memory");
            const unsigned og = xb_add(&bar[XB_TOP], 1u);
            const unsigned tg = og / nx;
            if (og + 1u == (tg + 1u) * nx) xb_add(&bar[XB_TOPGEN], 1u);
            else XB_SPIN(xb_ld(&bar[XB_TOPGEN]) == tg, bar);
            __builtin_amdgcn_fence(__ATOMIC_ACQUIRE, "agent");
            xb_add(&bar[XB_XGEN(b.x)], 1u);
            asm volatile("s_waitcnt vmcnt(0)" ::: "memory");
        } else {
            XB_SPIN(xb_ld(&bar[XB_XGEN(b.x)]) == gen, bar);
            __builtin_amdgcn_fence(__ATOMIC_ACQUIRE, "agent");
            asm volatile("s_waitcnt vmcnt(0)" ::: "memory");
        }
    }
    __syncthreads();
}

namespace pg8 {
constexpr int BM = 256, BK = 64, HALF = 128, HTB = HALF * BK * 2, STAGE_BYTES = 8 * HTB, NXCD = 8, WGM = 8;
__device__ __forceinline__ int lds_byte(int r, int c) { const int st = (r >> 4) * 2 + (c >> 5), rr = r & 15, cc = c & 31, ob = rr * 64 + cc * 2; return st * 1024 + (ob ^ (((ob >> 9) & 1) << 5)); }
__device__ __forceinline__ void stage_rc(int b, int& R, int& C) { const int st = b / 1024, sb = b % 1024, swz = sb ^ (((sb >> 9) & 1) << 5); R = (st >> 1) * 16 + swz / 64; C = (st & 1) * 32 + (swz % 64) / 2; }
__device__ __forceinline__ int perm32(int rho) { const int n = rho >> 4, i = rho & 15; return 8 * (i >> 2) + 4 * n + (i & 3); }

struct Unit { int pm, pn, z; };
struct Order {
    int nM, nN, nZ2, per, nwg, G, c;
    const char* A; const char* Bt; size_t tA, tB, zA1, zA2, zB1, zB2;
    __device__ __forceinline__ void init(const void* A_, int lda, const void* Bt_, int ldb, int nM_, int nN_, int nZ1, int nZ2_,
                                         size_t zA1_, size_t zA2_, size_t zB1_, size_t zB2_, int G_, int c_) {
        A = (const char*)A_; Bt = (const char*)Bt_; nM = nM_; nN = nN_; nZ2 = nZ2_; per = nM_ * nN_; nwg = per * nZ1 * nZ2_; G = G_; c = c_;
        tA = (size_t)BM * lda * 2; tB = (size_t)BM * ldb * 2; zA1 = zA1_; zA2 = zA2_; zB1 = zB1_; zB2 = zB2_;
    }
    __device__ __forceinline__ bool next(int i, Unit& u) const {
        const long L = (long)i * G + c; if (c < 0 || L >= nwg) return false;
        int wgid = (int)L; { const int q = nwg / NXCD, r = nwg % NXCD, xcd = wgid % NXCD, off = wgid / NXCD; wgid = (xcd < r ? xcd * (q + 1) : r * (q + 1) + (xcd - r) * q) + off; }
        u.z = wgid / per; const int w = wgid - u.z * per;
        const int nig = WGM * nN, gid = w / nig, fm = gid * WGM, gsz = (nM - fm) < WGM ? (nM - fm) : WGM;
        u.pm = fm + ((w % nig) % gsz); u.pn = (w % nig) / gsz; return true;
    }
    __device__ __forceinline__ const char* aptr(const Unit& u) const { return A + (size_t)(u.z / nZ2) * zA1 + (size_t)(u.z % nZ2) * zA2 + (size_t)u.pm * tA; }
    __device__ __forceinline__ const char* bptr(const Unit& u) const { return Bt + (size_t)(u.z / nZ2) * zB1 + (size_t)(u.z % nZ2) * zB2 + (size_t)u.pn * tB; }
};

template <class Epi>
__device__ __forceinline__ void gemm_phase(LAS unsigned char* lds, const int K, const int lda, const int ldb, const Order& S, const Epi& E) {
    const int tid = threadIdx.x, wid = __builtin_amdgcn_readfirstlane(tid >> 6), lane = tid & 63, wr = wid >> 2, wc = wid & 3, fr = lane & 15, fq = lane >> 4;
    const int nt = K / BK;
    unsigned voffA[2], voffB[2];
#pragma unroll
    for (int i = 0; i < 2; ++i) { int R, C; stage_rc(tid * 16 + i * 8192, R, C); const int Rb = Epi::PERM ? ((R & ~31) + perm32(R & 31)) : R;
        voffA[i] = (unsigned)(R * lda + C) * 2u; voffB[i] = (unsigned)(Rb * ldb + C) * 2u; }
    const size_t kstep = (size_t)(BK * 2);
    const size_t hstepA = (size_t)HALF * lda * 2, hstepB = (size_t)HALF * ldb * 2;
    const unsigned ldsw = (unsigned)wid * 1024u;
    const int aoff = lds_byte(wr * 64 + fr, fq * 8), boff = lds_byte(wc * 32 + fr, fq * 8);
#define PG8_SA(b, h) (((b) * 2 + (h)) * HTB)
#define PG8_SB(b, h) ((4 + (b) * 2 + (h)) * HTB)
#define PG8_STAGE(bufoff, gbase, voff) do { _Pragma("unroll") for (int _i = 0; _i < 2; ++_i) \
        __builtin_amdgcn_global_load_lds((const unsigned*)((const char*)(gbase) + (voff)[_i]), (LAS unsigned*)(lds + (bufoff) + ldsw + _i * 8192), 16, 0, 0); } while (0)
#define PG8_LDA(dst, b, h) do { _Pragma("unroll") for (int m = 0; m < 4; ++m) _Pragma("unroll") for (int k = 0; k < 2; ++k) dst[m][k] = *(const LAS bf16x8*)(lds + PG8_SA(b, h) + aoff + m * 2048 + k * 1024); } while (0)
#define PG8_LDB(dst, b, h) do { _Pragma("unroll") for (int n = 0; n < 2; ++n) _Pragma("unroll") for (int k = 0; k < 2; ++k) dst[n][k] = *(const LAS bf16x8*)(lds + PG8_SB(b, h) + boff + n * 2048 + k * 1024); } while (0)
#define PG8_MMA(ai, bj, At, Bt) do { __builtin_amdgcn_s_setprio(1); _Pragma("unroll") for (int m = 0; m < 4; ++m) _Pragma("unroll") for (int n = 0; n < 2; ++n) _Pragma("unroll") for (int k = 0; k < 2; ++k) \
        acc[ai][bj][m][n] = __builtin_amdgcn_mfma_f32_16x16x32_bf16(Bt[n][k], At[m][k], acc[ai][bj][m][n], 0, 0, 0); __builtin_amdgcn_s_setprio(0); } while (0)
#define PG8_WAIT_V(n) asm volatile("s_waitcnt vmcnt(" #n ")" ::: "memory")
#define PG8_WAIT_L(n) asm volatile("s_waitcnt lgkmcnt(" #n ")" ::: "memory")
#define PG8_BAR __builtin_amdgcn_s_barrier()
#define PG8_SCHED __builtin_amdgcn_sched_barrier(0)
    Unit cur, nxt; int ui = 0;
    if (!S.next(0, cur)) return;
    f32x4 acc[2][2][4][2];
#pragma unroll
    for (int a = 0; a < 2; ++a)
#pragma unroll
        for (int b = 0; b < 2; ++b)
#pragma unroll
            for (int m = 0; m < 4; ++m)
#pragma unroll
                for (int n = 0; n < 2; ++n) acc[a][b][m][n] = (f32x4){0.f, 0.f, 0.f, 0.f};
    bf16x8 At[4][2], B0[2][2], B1[2][2];
    const char* cA = S.aptr(cur); const char* cB = S.bptr(cur);
    PG8_STAGE(PG8_SB(0, 0), cB, voffB); PG8_STAGE(PG8_SB(0, 1), cB + hstepB, voffB); PG8_STAGE(PG8_SA(0, 0), cA, voffA); PG8_STAGE(PG8_SA(0, 1), cA + hstepA, voffA);
    if (wr == 1) PG8_BAR;
    PG8_WAIT_V(2); PG8_BAR;
    PG8_STAGE(PG8_SB(1, 0), cB + kstep, voffB); PG8_STAGE(PG8_SA(1, 0), cA + kstep, voffA); PG8_STAGE(PG8_SB(1, 1), cB + hstepB + kstep, voffB);
    PG8_WAIT_V(6); PG8_BAR;
    for (;;) {
        const bool has_next = S.next(ui + 1, nxt);
        const char* nA = has_next ? S.aptr(nxt) : cA; const char* nB = has_next ? S.bptr(nxt) : cB;
#pragma unroll 1
        for (int t = 0; t < nt; t += 2) {
            const bool last = (t == nt - 2);
            const char* a1 = cA + (size_t)(t + 1) * kstep;
            const char* a2 = last ? nA : cA + (size_t)(t + 2) * kstep; const char* b2 = last ? nB : cB + (size_t)(t + 2) * kstep;
            const char* a3 = a2 + kstep; const char* b3 = b2 + kstep;
            PG8_LDB(B0, 0, 0); PG8_LDB(B1, 0, 1); PG8_SCHED; PG8_LDA(At, 0, 0); PG8_STAGE(PG8_SA(1, 1), a1 + hstepA, voffA);
            PG8_WAIT_V(8); PG8_WAIT_L(0); PG8_BAR; PG8_MMA(0, 0, At, B0); PG8_MMA(0, 1, At, B1); PG8_BAR; PG8_SCHED;
            PG8_LDA(At, 0, 1); PG8_STAGE(PG8_SB(0, 0), b2, voffB); PG8_STAGE(PG8_SB(0, 1), b2 + hstepB, voffB); PG8_STAGE(PG8_SA(0, 0), a2, voffA);
            PG8_WAIT_V(8); PG8_WAIT_L(0); PG8_BAR; PG8_MMA(1, 0, At, B0); PG8_MMA(1, 1, At, B1); PG8_BAR; PG8_SCHED;
            PG8_LDB(B0, 1, 0); PG8_LDB(B1, 1, 1); PG8_SCHED; PG8_LDA(At, 1, 0); PG8_STAGE(PG8_SA(0, 1), a2 + hstepA, voffA);
            PG8_WAIT_V(8); PG8_WAIT_L(0); PG8_BAR; PG8_MMA(0, 0, At, B0); PG8_MMA(0, 1, At, B1); PG8_BAR; PG8_SCHED;
            PG8_LDA(At, 1, 1); PG8_STAGE(PG8_SB(1, 0), b3, voffB); PG8_STAGE(PG8_SB(1, 1), b3 + hstepB, voffB); PG8_STAGE(PG8_SA(1, 0), a3, voffA);
            PG8_WAIT_V(8); PG8_WAIT_L(0); PG8_BAR; PG8_MMA(1, 0, At, B0); PG8_MMA(1, 1, At, B1); PG8_BAR; PG8_SCHED;
        }
        if (wr == 0) PG8_BAR;
        E(acc, cur, wr, wc, fr, fq);
        if (!has_next) break;
#pragma unroll
        for (int a = 0; a < 2; ++a)
#pragma unroll
            for (int b = 0; b < 2; ++b)
#pragma unroll
                for (int m = 0; m < 4; ++m)
#pragma unroll
                    for (int n = 0; n < 2; ++n) acc[a][b][m][n] = (f32x4){0.f, 0.f, 0.f, 0.f};
        cur = nxt; cA = nA; cB = nB; ++ui;
        if (wr == 1) PG8_BAR;
    }
    PG8_WAIT_V(0);
    PG8_BAR;
#undef PG8_SA
#undef PG8_SB
#undef PG8_STAGE
#undef PG8_LDA
#undef PG8_LDB
#undef PG8_MMA
#undef PG8_WAIT_V
#undef PG8_WAIT_L
#undef PG8_BAR
#undef PG8_SCHED
}

template <int ACT>
__device__ __forceinline__ void store_tile_bf16(const f32x4 (&acc)[2][2][4][2], bf16_t* p0, bf16_t* p1, int ld0, int ld1, int nv0, int nv1, float scale, int wr, int wc, int fr, int fq) {
#pragma unroll
    for (int bj = 0; bj < 2; ++bj) {
        bf16_t* p = bj ? p1 : p0; const int ld = bj ? ld1 : ld0, nv = bj ? nv1 : nv0;
        if (p == nullptr || wc * 32 >= nv) continue;
#pragma unroll
        for (int ai = 0; ai < 2; ++ai)
#pragma unroll
            for (int m = 0; m < 4; ++m) {
                const int row = ai * HALF + wr * 64 + m * 16 + fr;
                f32x4 v0 = acc[ai][bj][m][0] * scale, v1 = acc[ai][bj][m][1] * scale;
                if (ACT == 1) {
#pragma unroll
                    for (int j = 0; j < 4; ++j) { const float a = fmaxf(v0[j], 0.f), b = fmaxf(v1[j], 0.f); v0[j] = a * a; v1[j] = b * b; } }
                u32x4 w; w.x = cvt_pk_bf16(v0[0], v0[1]); w.y = cvt_pk_bf16(v0[2], v0[3]); w.z = cvt_pk_bf16(v1[0], v1[1]); w.w = cvt_pk_bf16(v1[2], v1[3]);
                *(u32x4*)(p + (size_t)row * ld + wc * 32 + 8 * fq) = w;
            }
    }
}
struct EpiInProj {
    static constexpr bool PERM = true;
    bf16_t *zf, *cq, *ckv, *kr;
    __device__ __forceinline__ void operator()(const f32x4 (&acc)[2][2][4][2], const Unit& u, int wr, int wc, int fr, int fq) const {
        asm volatile("" : "+v"(fr), "+v"(fq));
        const size_t r0 = (size_t)u.pm * BM; bf16_t *p0, *p1; int ld, nv0 = 128, nv1 = 128;
        if (u.pn < 8)       { ld = FW;  p0 = zf + r0 * FW + u.pn * 256; p1 = p0 + 128; }
        else if (u.pn < 12) { ld = QR;  p0 = cq + r0 * QR + (u.pn - 8) * 256; p1 = p0 + 128; }
        else if (u.pn < 14) { ld = KVR; p0 = ckv + r0 * KVR + (u.pn - 12) * 256; p1 = p0 + 128; }
        else                { ld = DROPE; p0 = kr + r0 * DROPE; p1 = nullptr; nv0 = 64; nv1 = 0; }
        store_tile_bf16<0>(acc, p0, p1, ld, ld, nv0, nv1, 1.f, wr, wc, fr, fq);
    }
};
template <int ACT>
struct EpiBf16Lin {
    static constexpr bool PERM = true;
    bf16_t* out; int ld, nZ2; size_t sz1, sz2, spm, spn; float scale;
    __device__ __forceinline__ void operator()(const f32x4 (&acc)[2][2][4][2], const Unit& u, int wr, int wc, int fr, int fq) const {
        asm volatile("" : "+v"(fr), "+v"(fq));
        bf16_t* p0 = out + (size_t)(u.z / nZ2) * sz1 + (size_t)(u.z % nZ2) * sz2 + (size_t)u.pm * spm + (size_t)u.pn * spn;
        store_tile_bf16<ACT>(acc, p0, p0 + 128, ld, ld, 128, 128, scale, wr, wc, fr, fq);
    }
};
struct EpiQ {
    static constexpr bool PERM = true;
    bf16_t* Q; const float* rc; const float* rs;
    __device__ __forceinline__ void operator()(const f32x4 (&acc)[2][2][4][2], const Unit& u, int wr, int wc, int fr, int fq) const {
        asm volatile("" : "+v"(fr), "+v"(fq));
        const int colb = u.pn * 256 + wc * 32 + 8 * fq;
#pragma unroll
        for (int ai = 0; ai < 2; ++ai)
#pragma unroll
            for (int m = 0; m < 4; ++m) {
                const int row = u.pm * BM + ai * HALF + wr * 64 + m * 16 + fr;
#pragma unroll
                for (int bj = 0; bj < 2; ++bj) {
                    const int col = colb + bj * 128, w = col % DQK;
                    f32x4 v0 = acc[ai][bj][m][0], v1 = acc[ai][bj][m][1];
                    if (w >= DNOPE) {
                        const int p0 = (w - DNOPE) >> 1;
                        const f32x4 c = *(const f32x4*)(rc + (size_t)row * 32 + p0), s = *(const f32x4*)(rs + (size_t)row * 32 + p0);
                        const f32x4 a0 = v0, a1 = v1;
                        v0[0] = a0[0] * c[0] - a0[1] * s[0]; v0[1] = a0[0] * s[0] + a0[1] * c[0];
                        v0[2] = a0[2] * c[1] - a0[3] * s[1]; v0[3] = a0[2] * s[1] + a0[3] * c[1];
                        v1[0] = a1[0] * c[2] - a1[1] * s[2]; v1[1] = a1[0] * s[2] + a1[1] * c[2];
                        v1[2] = a1[2] * c[3] - a1[3] * s[3]; v1[3] = a1[2] * s[3] + a1[3] * c[3];
                    }
                    u32x4 o; o.x = cvt_pk_bf16(v0[0], v0[1]); o.y = cvt_pk_bf16(v0[2], v0[3]); o.z = cvt_pk_bf16(v1[0], v1[1]); o.w = cvt_pk_bf16(v1[2], v1[3]);
                    *(u32x4*)(Q + (size_t)row * (NH * DQK) + col) = o;
                }
                asm volatile("" ::: "memory");
            }
    }
};
struct EpiKV {
    static constexpr bool PERM = true;
    bf16_t *Kb, *Vb;
    __device__ __forceinline__ void operator()(const f32x4 (&acc)[2][2][4][2], const Unit& u, int wr, int wc, int fr, int fq) const {
        asm volatile("" : "+v"(fr), "+v"(fq));
        const size_t r0 = (size_t)u.pm * BM;
        store_tile_bf16<0>(acc, Kb + r0 * (NH * DQK) + u.pn * DQK, Vb + r0 * (NH * DV) + u.pn * DV, NH * DQK, NH * DV, 128, 128, 1.f, wr, wc, fr, fq);
    }
};
struct EpiF32 {
    static constexpr bool PERM = false;
    float* C; const float* R; int ldc; float scale; int rows_per_z;
    __device__ __forceinline__ void operator()(const f32x4 (&acc)[2][2][4][2], const Unit& u, int wr, int wc, int fr, int fq) const {
        asm volatile("" : "+v"(fr), "+v"(fq));
        const size_t row0 = (size_t)u.z * rows_per_z + (size_t)u.pm * BM + wr * 64 + fr; const int col0 = u.pn * BM + wc * 32 + 4 * fq;
#pragma unroll
        for (int ai = 0; ai < 2; ++ai)
#pragma unroll
            for (int m = 0; m < 4; ++m) { const size_t off = (row0 + ai * HALF + m * 16) * ldc + col0;
                f32x4 rv[2][2];
                if (R) {
#pragma unroll
                    for (int bj = 0; bj < 2; ++bj)
#pragma unroll
                        for (int n = 0; n < 2; ++n) rv[bj][n] = *(const f32x4*)(R + off + bj * HALF + n * 16); }
#pragma unroll
                for (int bj = 0; bj < 2; ++bj)
#pragma unroll
                    for (int n = 0; n < 2; ++n) { f32x4 o = acc[ai][bj][m][n] * scale; if (R) o += rv[bj][n]; *(f32x4*)(C + off + bj * HALF + n * 16) = o; }
            }
    }
};
}

namespace att {
constexpr int QBLK = 32, KVBLK = 64;
constexpr int LDQ = NH * DQK, LDK = NH * DQK, LDV = NH * DV, LDO = FW;
constexpr int KROW = 400;
constexpr int SHM_V = KVBLK * DV * 2, SHM_K = KVBLK * KROW, SHM_ATTN = 2 * SHM_V + 2 * SHM_K + NWAVES * 64 * 4;
static_assert(SHM_ATTN <= RING_BYTES, "attention LDS");
constexpr float THR = 11.54f;
#define SBAR() __builtin_amdgcn_sched_barrier(0)
__device__ __forceinline__ int crow(int r, int hi) { return (r & 3) + 8 * (r >> 2) + 4 * hi; }
__device__ __forceinline__ void partialSM(f32x16& p0, f32x16& p1, float& m_reg, float& mn, float& alpha) {
  float pmax = p0[0];
#pragma unroll
  for (int r = 1; r < 16; ++r) pmax = fmaxf(pmax, p0[r]);
#pragma unroll
  for (int r = 0; r < 16; ++r) pmax = fmaxf(pmax, p1[r]);
  { auto rr = __builtin_amdgcn_permlane32_swap(__float_as_uint(pmax), __float_as_uint(pmax), false, false);
    pmax = fmaxf(__uint_as_float(rr[0]), __uint_as_float(rr[1])); }
  if (__builtin_expect(__all(pmax - m_reg <= THR), 1)) { mn = m_reg; alpha = 1.f; }
  else { mn = fmaxf(m_reg, pmax); alpha = __builtin_amdgcn_exp2f(m_reg - mn); m_reg = mn; }
#pragma unroll
  for (int r = 0; r < 16; ++r) p0[r] = p0[r] - mn;
#pragma unroll
  for (int r = 0; r < 16; ++r) p1[r] = p1[r] - mn;
#pragma unroll
  for (int r = 0; r < 16; ++r) p0[r] = __builtin_amdgcn_exp2f(p0[r]);
}
__device__ __forceinline__ void finishSM(f32x16& p0, f32x16& p1, float alpha, float& l_reg, bf16x8& pa0, bf16x8& pa1, bf16x8& pa2, bf16x8& pa3) {
#pragma unroll
  for (int r = 0; r < 16; ++r) p1[r] = __builtin_amdgcn_exp2f(p1[r]);
  float ps = 0;
#pragma unroll
  for (int r = 0; r < 16; ++r) ps += p0[r];
#pragma unroll
  for (int r = 0; r < 16; ++r) ps += p1[r];
  { auto rr = __builtin_amdgcn_permlane32_swap(__float_as_uint(ps), __float_as_uint(ps), false, false);
    ps = __uint_as_float(rr[0]) + __uint_as_float(rr[1]); }
  l_reg = l_reg * alpha + ps;
#define PK4(P, BASE, OUT) do { unsigned a0 = cvt_pk_bf16(P[BASE + 0], P[BASE + 1]), a1 = cvt_pk_bf16(P[BASE + 2], P[BASE + 3]);   \
    unsigned b0 = cvt_pk_bf16(P[BASE + 4], P[BASE + 5]), b1 = cvt_pk_bf16(P[BASE + 6], P[BASE + 7]);                              \
    auto r0 = __builtin_amdgcn_permlane32_swap(a0, b0, false, false); auto r1 = __builtin_amdgcn_permlane32_swap(a1, b1, false, false); \
    u32x4 w = {r0[0], r1[0], r0[1], r1[1]}; OUT = *reinterpret_cast<bf16x8*>(&w); } while (0)
  PK4(p0, 0, pa0); PK4(p0, 8, pa1); PK4(p1, 0, pa2); PK4(p1, 8, pa3);
#undef PK4
}
__device__ __forceinline__ void qkt(f32x16& p0, f32x16& p1, const char* Ks, const bf16x8 (&qr)[12], int r32, int hi) {
  p0 = f32x16{}; p1 = f32x16{};
#pragma unroll
  for (int d0 = 0; d0 < 12; ++d0) { const int cb = (d0 * 16 + hi * 8) * 2;
    bf16x8 b0 = *reinterpret_cast<const bf16x8*>(Ks + r32 * KROW + cb);
    bf16x8 b1 = *reinterpret_cast<const bf16x8*>(Ks + (32 + r32) * KROW + cb);
    p0 = __builtin_amdgcn_mfma_f32_32x32x16_bf16(b0, qr[d0], p0, 0, 0, 0);
    p1 = __builtin_amdgcn_mfma_f32_32x32x16_bf16(b1, qr[d0], p1, 0, 0, 0); }
}
__device__ __forceinline__ int v_st(int k, int c) { const int kk = (k & ~0xC) | ((k & 4) << 1) | ((k & 8) >> 1); return ((kk >> 3) * 4 + (c >> 5)) * 512 + ((kk & 7) * 32 + (c & 31)) * 2; }
__device__ __forceinline__ int v_rd_base(int lane) { return ((lane & 3) << 3) | (((lane >> 2) & 3) << 6) | (((lane >> 4) & 1) << 5) | (((lane >> 5) & 1) << 8); }
constexpr int v_rd_off(int d0, int ks, int half) { return d0 * 512 + ks * 4096 + half * 2048; }
template <int OFF> __device__ __forceinline__ s16x4 tr_read(int vb) {
  s16x4 r; asm volatile("ds_read_b64_tr_b16 %0, %1 offset:%2" : "=&v"(r) : "v"(vb), "i"(OFF) : "memory"); return r;
}
template <int D0> __device__ __forceinline__ void pv_one(f32x16& od, int vb, bf16x8 pa0, bf16x8 pa1, bf16x8 pa2, bf16x8 pa3) {
  const s16x4 l0 = tr_read<v_rd_off(D0, 0, 0)>(vb), h0 = tr_read<v_rd_off(D0, 0, 1)>(vb), l1 = tr_read<v_rd_off(D0, 1, 0)>(vb), h1 = tr_read<v_rd_off(D0, 1, 1)>(vb);
  const s16x4 l2 = tr_read<v_rd_off(D0, 2, 0)>(vb), h2 = tr_read<v_rd_off(D0, 2, 1)>(vb), l3 = tr_read<v_rd_off(D0, 3, 0)>(vb), h3 = tr_read<v_rd_off(D0, 3, 1)>(vb);
  asm volatile("s_waitcnt lgkmcnt(0)" ::: "memory"); SBAR();
#define PK(L, H) (bf16x8){L[0], L[1], L[2], L[3], H[0], H[1], H[2], H[3]}
  od = __builtin_amdgcn_mfma_f32_32x32x16_bf16(pa0, PK(l0, h0), od, 0, 0, 0);
  od = __builtin_amdgcn_mfma_f32_32x32x16_bf16(pa1, PK(l1, h1), od, 0, 0, 0);
  od = __builtin_amdgcn_mfma_f32_32x32x16_bf16(pa2, PK(l2, h2), od, 0, 0, 0);
  od = __builtin_amdgcn_mfma_f32_32x32x16_bf16(pa3, PK(l3, h3), od, 0, 0, 0);
#undef PK
}
__device__ __forceinline__ void pv_d0(f32x16* o, int vb, bf16x8 pa0, bf16x8 pa1, bf16x8 pa2, bf16x8 pa3) {
  pv_one<0>(o[0], vb, pa0, pa1, pa2, pa3); pv_one<1>(o[1], vb, pa0, pa1, pa2, pa3); pv_one<2>(o[2], vb, pa0, pa1, pa2, pa3); pv_one<3>(o[3], vb, pa0, pa1, pa2, pa3);
}
__device__ __forceinline__ void attn_body(const bf16_t* __restrict__ Qb, const bf16_t* __restrict__ Kh, const bf16_t* __restrict__ Vh, bf16_t* __restrict__ Ob, int seq, char* lds) {
  const int tid = threadIdx.x, wid = tid >> 6, lane = tid & 63, r32 = lane & 31, hi = lane >> 5;
  char* V_lds = lds; char* K_lds = lds + 2 * SHM_V;
  float* ws = (float*)(lds + 2 * SHM_V + 2 * SHM_K) + wid * 64; float* li_l = ws; float* al_l = ws + 32;
  float m_reg = -1e30f, l_reg = 0; f32x16 o[4] = {}; bf16x8 qr[12];
  const bf16_t* Qw = Qb + (long)(wid * QBLK + r32) * LDQ + hi * 8;
#pragma unroll
  for (int d0 = 0; d0 < 12; ++d0) qr[d0] = *reinterpret_cast<const bf16x8*>(Qw + d0 * 16);
  const int sr = tid >> 4, sc = (tid & 15) * 8, vst0 = v_st(sr, sc), vst1 = v_st(32 + sr, sc);
  int krow[3], kcc[3];
#pragma unroll
  for (int i = 0; i < 3; ++i) { const int c = tid + 512 * i; krow[i] = c / 24; kcc[i] = c % 24; }
  const int vb0 = (int)(uintptr_t)V_lds + v_rd_base(lane);
  struct { bf16x8 vs0, vs1, k0, k1, k2; } st_[1];
#define SLOAD(i, kk0) do { st_[i].vs0 = *reinterpret_cast<const bf16x8*>(&Vh[(long)((kk0) + sr) * LDV + sc]); st_[i].vs1 = *reinterpret_cast<const bf16x8*>(&Vh[(long)((kk0) + 32 + sr) * LDV + sc]); \
    st_[i].k0 = *reinterpret_cast<const bf16x8*>(&Kh[(long)((kk0) + krow[0]) * LDK + kcc[0] * 8]); st_[i].k1 = *reinterpret_cast<const bf16x8*>(&Kh[(long)((kk0) + krow[1]) * LDK + kcc[1] * 8]); \
    st_[i].k2 = *reinterpret_cast<const bf16x8*>(&Kh[(long)((kk0) + krow[2]) * LDK + kcc[2] * 8]); } while (0)
#define SWRITE(b, i) do { *(bf16x8*)(V_lds + (b) * SHM_V + vst0) = st_[i].vs0; *(bf16x8*)(V_lds + (b) * SHM_V + vst1) = st_[i].vs1; \
    *(bf16x8*)(K_lds + (b) * SHM_K + krow[0] * KROW + kcc[0] * 16) = st_[i].k0; *(bf16x8*)(K_lds + (b) * SHM_K + krow[1] * KROW + kcc[1] * 16) = st_[i].k1; \
    *(bf16x8*)(K_lds + (b) * SHM_K + krow[2] * KROW + kcc[2] * 16) = st_[i].k2; } while (0)
#define RESC(a) do { if (__any((a) < 1.f)) { if (hi == 0) al_l[r32] = (a); asm volatile("s_waitcnt lgkmcnt(0)" ::: "memory"); \
    _Pragma("unroll") for (int d = 0; d < 4; ++d) _Pragma("unroll") for (int r = 0; r < 16; ++r) o[d][r] *= al_l[crow(r, hi)]; } } while (0)
  f32x16 pA0, pA1; float mnA, alA; bf16x8 pa0, pa1, pa2, pa3; const int NT = seq / KVBLK;
  SLOAD(0, 0); asm volatile("s_waitcnt vmcnt(0)" ::: "memory"); SWRITE(0, 0); __syncthreads();
  for (int j = 0; j < NT; ++j) {
    const int buf = j & 1;
    if (j + 1 < NT) SLOAD(0, (j + 1) * KVBLK);
    SBAR(); qkt(pA0, pA1, K_lds + buf * SHM_K, qr, r32, hi);
    partialSM(pA0, pA1, m_reg, mnA, alA);
    RESC(alA);
    finishSM(pA0, pA1, alA, l_reg, pa0, pa1, pa2, pa3); SBAR();
    pv_d0(o, vb0 + buf * SHM_V, pa0, pa1, pa2, pa3);
    if (j + 1 < NT) { asm volatile("s_waitcnt vmcnt(0)" ::: "memory"); SWRITE(buf ^ 1, 0); }
    __syncthreads();
  }
  if (hi == 0) li_l[r32] = l_reg; asm volatile("s_waitcnt lgkmcnt(0)" ::: "memory");
  float rli[16];
#pragma unroll
  for (int r = 0; r < 16; ++r) rli[r] = __builtin_amdgcn_rcpf(li_l[crow(r, hi)]);
  bf16_t* Ow = Ob + (long)(wid * QBLK) * LDO;
#pragma unroll
  for (int r = 0; r < 16; ++r) { const int orow = crow(r, hi);
#pragma unroll
    for (int d0 = 0; d0 < 4; ++d0) Ow[(long)orow * LDO + d0 * 32 + r32] = (bf16_t)(cvt_pk_bf16(o[d0][r] * rli[r], 0.f) & 0xffffu); }
  __syncthreads();
#undef SLOAD
#undef SWRITE
#undef RESC
}
}

struct Ctx {
    LAS unsigned char* lds; int tid, lane, wave, G, bid, gw, ngw;
};
template <int MODE>
__device__ __forceinline__ void transpose_item(const float* W, int K, int N, bf16_t* WT, float scale, LAS float* scr, int item, int lane) {
    const int nblk = N / 32, kb = item / nblk, nb = item % nblk, k0 = 64 * kb, n0 = 32 * nb;
#pragma unroll 8
    for (int i = 0; i < 32; ++i) { const int kk = 2 * i + (lane >> 5); scr[kk * 33 + (lane & 31)] = W[(size_t)(k0 + kk) * N + n0 + (lane & 31)]; }
    LDS_WAIT(); asm volatile("" ::: "memory");
    const int c = lane & 7;
#pragma unroll
    for (int j = 0; j < 4; ++j) { const int n = (lane >> 3) + 8 * j; const LAS float* s = scr + (8 * c) * 33 + n;
        int no = n0 + n;
        if (MODE == 1) { const int h = no / DQK, w = no % DQK; const int w2 = (w < DNOPE) ? w : ((w < DNOPE + 32) ? DNOPE + 2 * (w - DNOPE) : DNOPE + 2 * (w - DNOPE - 32) + 1); no = h * DQK + w2; }
        u32x4 o; o.x = cvt_pk_bf16(s[0 * 33] * scale, s[1 * 33] * scale); o.y = cvt_pk_bf16(s[2 * 33] * scale, s[3 * 33] * scale);
        o.z = cvt_pk_bf16(s[4 * 33] * scale, s[5 * 33] * scale); o.w = cvt_pk_bf16(s[6 * 33] * scale, s[7 * 33] * scale);
        *(u32x4*)(WT + (size_t)no * K + k0 + 8 * c) = o; }
    LDS_WAIT(); asm volatile("" ::: "memory");
}
template <int MODE>
__device__ __forceinline__ void convert_transpose(const Ctx& F, const float* W, int K, int N, bf16_t* WT, float scale) {
    LAS float* scr = (LAS float*)(F.lds + F.wave * 8704);
    const int nitems = (K / 64) * (N / 32);
    for (int it = F.gw; it < nitems; it += F.ngw) transpose_item<MODE>(W, K, N, WT, scale, scr, it, F.lane);
}
__device__ __forceinline__ void convert_plain(const Ctx& F, const float* W, bf16_t* O, size_t n8) {
    for (size_t i = (size_t)F.bid * NTHR + F.tid; i < n8; i += (size_t)F.G * NTHR) {
        const f32x4 a = *(const f32x4*)(W + i * 8), b = *(const f32x4*)(W + i * 8 + 4);
        u32x4 o; o.x = cvt_pk_bf16(a[0], a[1]); o.y = cvt_pk_bf16(a[2], a[3]); o.z = cvt_pk_bf16(b[0], b[1]); o.w = cvt_pk_bf16(b[2], b[3]);
        *(u32x4*)(O + i * 8) = o; }
}
template <bool OUTF32>
__device__ __forceinline__ void rms_row4096(const float* xrow, const float* g, void* orow, int lane) {
    const f32x4* xr = (const f32x4*)xrow + lane; f32x4 v[16]; float s = 0.f;
#pragma unroll
    for (int j = 0; j < 16; ++j) { v[j] = xr[64 * j]; s += (v[j][0] * v[j][0] + v[j][1] * v[j][1]) + (v[j][2] * v[j][2] + v[j][3] * v[j][3]); }
    const float rstd = rsqrtf(wave_sum(s) * (1.f / DM) + NORM_EPS);
    const f32x4* gr = (const f32x4*)g + lane;
#pragma unroll
    for (int j = 0; j < 16; ++j) { const f32x4 gv = gr[64 * j]; const f32x4 o = v[j] * rstd * gv;
        if (OUTF32) ((f32x4*)orow)[lane + 64 * j] = o;
        else { u32x2 w; w.x = cvt_pk_bf16(o[0], o[1]); w.y = cvt_pk_bf16(o[2], o[3]); ((u32x2*)orow)[lane + 64 * j] = w; } }
}
__device__ __forceinline__ void rms_rows(const Ctx& F, const float* X, const float* g, bf16_t* O, int rows) {
    for (int m = F.gw; m < rows; m += F.ngw) rms_row4096<false>(X + (size_t)m * DM, g, O + (size_t)m * DM, F.lane);
}
__device__ __forceinline__ void sincos_rev(double r, float& s, float& c) {
    const double q = __builtin_rint(r * 4.0); const double y = (r - q * 0.25) * 6.283185307179586476925;
    const double y2 = y * y;
    const double sp = y * (1.0 + y2 * (-1.0 / 6 + y2 * (1.0 / 120 + y2 * (-1.0 / 5040 + y2 * (1.0 / 362880 + y2 * (-1.0 / 39916800 + y2 * (1.0 / 6227020800.0)))))));
    const double cp = 1.0 + y2 * (-0.5 + y2 * (1.0 / 24 + y2 * (-1.0 / 720 + y2 * (1.0 / 40320 + y2 * (-1.0 / 3628800 + y2 * (1.0 / 479001600.0 + y2 * (-1.0 / 87178291200.0)))))));
    const int qi = ((int)q) & 3;
    const double ss = (qi == 0) ? sp : (qi == 1) ? cp : (qi == 2) ? -sp : -cp;
    const double cc = (qi == 0) ? cp : (qi == 1) ? -sp : (qi == 2) ? -cp : sp;
    s = (float)ss; c = (float)cc;
}
__constant__ float INV_FREQ[32] = {1.000000000e+00f, 7.498942018e-01f, 5.623413324e-01f, 4.216965139e-01f, 3.162277639e-01f, 2.371373773e-01f, 1.778279394e-01f, 1.333521456e-01f,
    1.000000015e-01f, 7.498942316e-02f, 5.623413250e-02f, 4.216964915e-02f, 3.162277490e-02f, 2.371373773e-02f, 1.778279431e-02f, 1.333521400e-02f,
    9.999999776e-03f, 7.498942316e-03f, 5.623413250e-03f, 4.216964822e-03f, 3.162277630e-03f, 2.371373819e-03f, 1.778279431e-03f, 1.333521446e-03f,
    1.000000047e-03f, 7.498941850e-04f, 5.623413017e-04f, 4.216965172e-04f, 3.162277571e-04f, 2.371373703e-04f, 1.778279402e-04f, 1.333521504e-04f};

struct Args { const void* in[23]; float* out; unsigned char* ws; int ph_lo, ph_hi; };
constexpr int N_PHASES = 15;

__global__ void __launch_bounds__(NTHR, 2) mk_fwd(Args args) {
    extern __shared__ __attribute__((aligned(16))) unsigned char lds_raw[];
    Ctx F; F.lds = (LAS unsigned char*)lds_raw; F.tid = threadIdx.x; F.lane = F.tid & 63; F.wave = __builtin_amdgcn_readfirstlane(F.tid >> 6);
    F.G = gridDim.x; F.bid = blockIdx.x; F.gw = F.bid * NWAVES + F.wave; F.ngw = F.G * NWAVES;
    volatile LAS unsigned* MISC = (volatile LAS unsigned*)(F.lds + MISC_OFF);
    unsigned char* ws = args.ws;
    unsigned* ctl = (unsigned*)(ws + WS_CTL);
#define INP(i) ((const float*)args.in[i])
#define in_x INP(0)
#define in_mem INP(1)
#define positions ((const int*)args.in[2])
#define g_mix INP(3)
#define w_in INP(4)
#define w_fourier INP(5)
#define g_q_lora INP(6)
#define w_uq INP(7)
#define g_kv_lora INP(8)
#define w_ukv INP(9)
#define g_fourier_out INP(10)
#define g_mla_out INP(11)
#define w_out INP(12)
#define g_xattn INP(13)
#define g_mem INP(14)
#define w_xq INP(15)
#define w_xk INP(16)
#define w_xv INP(17)
#define w_xo INP(18)
#define g_mlp INP(19)
#define w_ff1 INP(20)
#define w_ff2 INP(21)
#define g_final INP(22)
#define hbuf (args.out)
#define WSP(T, off) ((T*)(ws + (off)))
#define ropec WSP(float, WS_ROPEC)
#define ropes WSP(float, WS_ROPES)
#define y4096 WSP(float, WS_Y4096)
#define memn WSP(bf16_t, WS_MEMN)
#define KVx WSP(bf16_t, WS_KX)
#define WuqT WSP(bf16_t, WS_WUQT)
#define WukvT WSP(bf16_t, WS_WUKVT)
#define MgT WSP(bf16_t, WS_MGT)
#define MT WSP(bf16_t, WS_MT)
#define NVT WSP(bf16_t, WS_NVT)
#define XN WSP(bf16_t, WS_XN)
#define TT WSP(bf16_t, WS_TT)
#define Cs WSP(bf16_t, WS_CS)
#define Ss WSP(bf16_t, WS_SS)
#define Y WSP(bf16_t, WS_Y)
#define Abuf WSP(bf16_t, WS_A)
#define zf WSP(bf16_t, WS_ZF)
#define cq WSP(bf16_t, WS_CQ)
#define ckv WSP(bf16_t, WS_CKV)
#define krope WSP(bf16_t, WS_KROPE)
#define Ct WSP(float, WS_CT)
#define Dt WSP(float, WS_DT)
#define WinT WSP(bf16_t, WS_WINT)
#define WxkT WSP(bf16_t, WS_WXKT)
#define WxvT WSP(bf16_t, WS_WXVT)
#define Qb WSP(bf16_t, WS_Q)
#define Kb WSP(bf16_t, WS_K)
#define Vb WSP(bf16_t, WS_V)
#define yA WSP(bf16_t, WS_YA)
#define SC WSP(float, WS_SC)
#define WoutT WSP(bf16_t, WS_WOUTT)
#define Pb WSP(bf16_t, WS_P)
#define Wxq WSP(bf16_t, WS_WXQ)
#define WxoT WSP(bf16_t, WS_WXOT)
#define W1T WSP(bf16_t, WS_W1T)
#define W2T WSP(bf16_t, WS_W2T)

    if (F.tid < 64) MISC[F.tid] = 0u;
    __syncthreads();
#if !MK_PER_PHASE
    XcdBarrier bar = xcd_barrier_post(ctl + CW_BAR, MISC + 8);
#define GRID_BAR() xcd_barrier(bar)
#else
#define GRID_BAR() do {} while (0)
#endif
    const int lo = args.ph_lo, hi = args.ph_hi;
#ifndef PH_MASK
#define PH_MASK 0x7fff
#endif
#define IN(k) (((PH_MASK >> (k)) & 1) && lo <= (k) && (k) < hi)
#define SEAM(k) do { if (IN((k) + 1)) GRID_BAR(); } while (0)
    const int G = F.G, cid = F.bid;

    if (IN(0)) {
        rms_rows(F, in_x, g_mix, XN, NTOK);
        rms_rows(F, in_mem, g_mem, memn, NB * MEMT);
        convert_transpose<0>(F, w_in, DM, INW, WinT, 1.f);
        for (size_t i = (size_t)F.bid * NTHR + F.tid; i < (size_t)(INWP - INW) * DM / 8; i += (size_t)G * NTHR) *(u32x4*)(WinT + (size_t)INW * DM + i * 8) = (u32x4){0u, 0u, 0u, 0u};
        convert_transpose<0>(F, w_xk, DM, DM, WxkT, 1.f);
        convert_transpose<0>(F, w_xv, DM, DM, WxvT, 1.f);
        convert_transpose<1>(F, w_uq, QR, NH * DQK, WuqT, 0.10411754627697264f);
        convert_transpose<0>(F, w_ukv, KVR, NH * (DNOPE + DV), WukvT, 1.f);
        for (int i = F.bid * NTHR + F.tid; i < NTOK * 32; i += G * NTHR) { const int t = i >> 5, j = i & 31;
            const float ang = (float)positions[t] * INV_FREQ[j];
            double r = (double)ang * 0.15915494309189533577; r -= __builtin_floor(r);
            float s, c; sincos_rev(r, s, c); ropec[i] = c; ropes[i] = s; }
        for (int i = F.bid * NTHR + F.tid; i < (SEQ / 2) * (SEQ / 8); i += G * NTHR) { const int k = i / (SEQ / 8), s0 = (i % (SEQ / 8)) * 8;
            unsigned cw[4], sw[4];
#pragma unroll
            for (int j = 0; j < 4; ++j) { const float f0 = (float)((k * (s0 + 2 * j)) & (SEQ - 1)) * (1.f / SEQ), f1 = (float)((k * (s0 + 2 * j + 1)) & (SEQ - 1)) * (1.f / SEQ);
                cw[j] = cvt_pk_bf16(__builtin_amdgcn_cosf(f0), __builtin_amdgcn_cosf(f1)); sw[j] = cvt_pk_bf16(__builtin_amdgcn_sinf(f0), __builtin_amdgcn_sinf(f1)); }
            *(u32x4*)(Cs + (size_t)k * SEQ + s0) = (u32x4){cw[0], cw[1], cw[2], cw[3]}; *(u32x4*)(Ss + (size_t)k * SEQ + s0) = (u32x4){sw[0], sw[1], sw[2], sw[3]}; }
        for (int i = F.bid * NTHR + F.tid; i < FG * FC * FC; i += G * NTHR) { const int c = i & 255, d = (i >> 8) & 255, g = i >> 16;
            float ar = 0.f, ai = 0.f; const float* wf = w_fourier + (size_t)g * FC * FC + d;
            for (int l = 0; l < FC; ++l) { const float w = wf[(size_t)l * FC], f = (float)((l * c) & 255) * (1.f / 256.f); ar += __builtin_amdgcn_cosf(f) * w; ai -= __builtin_amdgcn_sinf(f) * w; }
            MgT[((size_t)g * 512 + d) * FC + c] = (bf16_t)(cvt_pk_bf16(ar * 0.0625f, 0.f) & 0xffffu); MgT[((size_t)g * 512 + 256 + d) * FC + c] = (bf16_t)(cvt_pk_bf16(ai * 0.0625f, 0.f) & 0xffffu); }
        SEAM(0);
    }
    if (IN(1)) {
        { pg8::Order S; S.init(XN, DM, WinT, DM, NTOK / 256, INWP / 256, 1, 1, 0, 0, 0, 0, G, cid);
          pg8::EpiInProj E{zf, cq, ckv, krope}; pg8::gemm_phase(F.lds, DM, DM, DM, S, E); }
        { const int sh = ((NTOK / 256) * (INWP / 256)) % G; pg8::Order S; S.init(memn, DM, WxkT, DM, (NB * MEMT) / 256, 2 * DM / 256, 1, 1, 0, 0, 0, 0, G, (cid - sh + G) % G);
          pg8::EpiBf16Lin<0> E{KVx, 2 * DM, 1, 0, 0, (size_t)256 * 2 * DM, 256, 1.f};
          pg8::gemm_phase(F.lds, DM, DM, DM, S, E); }
        SEAM(1);
    }
    if (IN(2)) {
        for (int t = F.gw; t < NTOK; t += F.ngw) {
            { u32x4* p = (u32x4*)(cq + (size_t)t * QR) + F.lane; u32x4 a = p[0], b = p[64]; float s = 0.f;
#pragma unroll
              for (int j = 0; j < 4; ++j) { const float a0 = bflo(a[j]), a1 = bfhi(a[j]), b0 = bflo(b[j]), b1 = bfhi(b[j]); s += a0 * a0 + a1 * a1 + b0 * b0 + b1 * b1; }
              const float rstd = rsqrtf(wave_sum(s) * (1.f / QR) + NORM_EPS);
              const f32x4* gp = (const f32x4*)g_q_lora + F.lane * 2; const f32x4 g0 = gp[0], g1 = gp[1], g2 = gp[128], g3 = gp[129];
              u32x4 oa, ob;
              oa.x = cvt_pk_bf16(bflo(a.x) * rstd * g0[0], bfhi(a.x) * rstd * g0[1]); oa.y = cvt_pk_bf16(bflo(a.y) * rstd * g0[2], bfhi(a.y) * rstd * g0[3]);
              oa.z = cvt_pk_bf16(bflo(a.z) * rstd * g1[0], bfhi(a.z) * rstd * g1[1]); oa.w = cvt_pk_bf16(bflo(a.w) * rstd * g1[2], bfhi(a.w) * rstd * g1[3]);
              ob.x = cvt_pk_bf16(bflo(b.x) * rstd * g2[0], bfhi(b.x) * rstd * g2[1]); ob.y = cvt_pk_bf16(bflo(b.y) * rstd * g2[2], bfhi(b.y) * rstd * g2[3]);
              ob.z = cvt_pk_bf16(bflo(b.z) * rstd * g3[0], bfhi(b.z) * rstd * g3[1]); ob.w = cvt_pk_bf16(bflo(b.w) * rstd * g3[2], bfhi(b.w) * rstd * g3[3]);
              p[0] = oa; p[64] = ob; }
            { u32x4* p = (u32x4*)(ckv + (size_t)t * KVR) + F.lane; u32x4 a = p[0]; float s = 0.f;
#pragma unroll
              for (int j = 0; j < 4; ++j) { const float a0 = bflo(a[j]), a1 = bfhi(a[j]); s += a0 * a0 + a1 * a1; }
              const float rstd = rsqrtf(wave_sum(s) * (1.f / KVR) + NORM_EPS);
              const f32x4* gp = (const f32x4*)g_kv_lora + F.lane * 2; const f32x4 g0 = gp[0], g1 = gp[1];
              u32x4 oa;
              oa.x = cvt_pk_bf16(bflo(a.x) * rstd * g0[0], bfhi(a.x) * rstd * g0[1]); oa.y = cvt_pk_bf16(bflo(a.y) * rstd * g0[2], bfhi(a.y) * rstd * g0[3]);
              oa.z = cvt_pk_bf16(bflo(a.z) * rstd * g1[0], bfhi(a.z) * rstd * g1[1]); oa.w = cvt_pk_bf16(bflo(a.w) * rstd * g1[2], bfhi(a.w) * rstd * g1[3]);
              p[0] = oa; }
            if (F.lane < 32) { const int p = F.lane; const float t1 = bf2f(krope[(size_t)t * DROPE + p]), t2 = bf2f(krope[(size_t)t * DROPE + 32 + p]);
              const float c = ropec[(size_t)t * 32 + p], s = ropes[(size_t)t * 32 + p];
              const unsigned w = cvt_pk_bf16(t1 * c - t2 * s, t1 * s + t2 * c);
              unsigned* kp = (unsigned*)(Kb + (size_t)t * (NH * DQK) + DNOPE) + p;
#pragma unroll
              for (int h = 0; h < NH; ++h) kp[h * (DQK / 2)] = w; }
        }
        convert_plain(F, w_xq, Wxq, (size_t)DM * DM / 8);
        convert_transpose<0>(F, w_xo, DM, DM, WxoT, 1.f);
        convert_transpose<0>(F, w_out, DM, DM, WoutT, 1.f);
        SEAM(2);
    }
    if (IN(3)) {
#ifndef P3M
#define P3M 31
#endif
        if (P3M & 1) {
          pg8::Order S; S.init(MgT, FC, zf, FW, 2, SEQ / 256, NB, FG, 0, (size_t)512 * FC * 2, (size_t)SEQ * FW * 2, (size_t)FC * 2, G, cid);
          pg8::EpiBf16Lin<0> E{TT, 2 * SEQ, 1, (size_t)256 * 2 * SEQ, 0, (size_t)SEQ, 256, 1.f}; pg8::gemm_phase(F.lds, FC, FC, FW, S, E); }
        if (P3M & 2) { pg8::Order S; S.init(cq, QR, WuqT, QR, NTOK / 256, (NH * DQK) / 256, 1, 1, 0, 0, 0, 0, G, cid);
          pg8::EpiQ E{Qb, ropec, ropes}; pg8::gemm_phase(F.lds, QR, QR, QR, S, E); }
        if (P3M & 4) { pg8::Order S; S.init(ckv, KVR, WukvT, KVR, NTOK / 256, NH, 1, 1, 0, 0, 0, 0, G, cid);
          pg8::EpiKV E{Kb, Vb}; pg8::gemm_phase(F.lds, KVR, KVR, KVR, S, E); }
        if (P3M & 8) {
          pg8::Order S; S.init(KVx, 2 * DM, Wxq, DM, 1, DM / 256, NB, XH, (size_t)MEMT * 2 * DM * 2, (size_t)XHD * 2, 0, (size_t)XHD * 2, G, cid);
          pg8::EpiBf16Lin<0> E{MT, DM, XH, (size_t)XH * MEMT * DM, (size_t)MEMT * DM, 0, 256, 1.f}; pg8::gemm_phase(F.lds, XHD, 2 * DM, DM, S, E); }
        if (P3M & 16) {
          const int sh = (NB * XH * (DM / 256)) % G; pg8::Order S; S.init(WxoT, DM, KVx + DM, 2 * DM, DM / 256, 1, NB, XH, 0, (size_t)XHD * 2, (size_t)MEMT * 2 * DM * 2, (size_t)XHD * 2, G, (cid - sh + G) % G);
          pg8::EpiBf16Lin<0> E{NVT, XH * MEMT, XH, (size_t)DM * XH * MEMT, (size_t)MEMT, (size_t)256 * XH * MEMT, 0, 1.f}; pg8::gemm_phase(F.lds, XHD, DM, 2 * DM, S, E); }
        SEAM(3);
    }
    if (IN(4)) {
        for (int i = 0;; ++i) { const int L = i * G + cid; if (L >= NB * NH * (SEQ / 256)) break;
            int bh, qb; if (G == 256) { bh = i * 8 + (cid & 7); qb = cid >> 3; } else { bh = L / (SEQ / 256); qb = L % (SEQ / 256); }
            const int b = bh / NH, h = bh % NH; const size_t t0 = (size_t)b * SEQ;
            att::attn_body(Qb + (t0 + (size_t)qb * 256) * (NH * DQK) + h * DQK, Kb + t0 * (NH * DQK) + h * DQK, Vb + t0 * (NH * DV) + h * DV,
                           yA + (t0 + (size_t)qb * 256) * FW + h * DV, SEQ, (char*)lds_raw); }
        { pg8::Order S; S.init(Ss, SEQ, TT + SEQ, 2 * SEQ, (SEQ / 2) / 256, (NB * FW) / 256, 1, 1, 0, 0, 0, 0, G, cid);
          pg8::EpiF32 E{Dt, nullptr, NB * FW, 1.f, 0}; pg8::gemm_phase(F.lds, SEQ, SEQ, 2 * SEQ, S, E); }
        { pg8::Order S; S.init(Cs, SEQ, TT, 2 * SEQ, (SEQ / 2) / 256, (NB * FW) / 256, 1, 1, 0, 0, 0, 0, G, cid);
          pg8::EpiF32 E{Ct, nullptr, NB * FW, 1.f, 0}; pg8::gemm_phase(F.lds, SEQ, SEQ, 2 * SEQ, S, E); }
        for (int col = F.gw; col < NB * FW; col += F.ngw) {
            const u32x4* p = (const u32x4*)(TT + (size_t)col * 2 * SEQ) + F.lane; float s = 0.f;
#pragma unroll 4
            for (int j = 0; j < SEQ / 512; ++j) { const u32x4 v = p[64 * j];
#pragma unroll
                for (int q = 0; q < 4; ++q) s += bflo(v[q]) - bfhi(v[q]); }
            s = wave_sum(s); if (F.lane == 0) y4096[col] = s; }
        SEAM(4);
    }
    if (IN(5)) {
        const float isq = 0.011048543456039804f;
        for (int t = F.gw; t < NTOK; t += F.ngw) { const int b = t / SEQ, s = t % SEQ; const int k = (s <= SEQ / 2) ? s : SEQ - s; const float sg = (s <= SEQ / 2) ? 1.f : -1.f;
            f32x4 v[8]; float ss = 0.f;
#pragma unroll
            for (int j = 0; j < 8; ++j) { const int col = F.lane * 4 + 256 * j;
                if (s == SEQ / 2) v[j] = *(const f32x4*)(y4096 + b * FW + col) * isq;
                else { const f32x4 c = *(const f32x4*)(Ct + (size_t)k * (NB * FW) + b * FW + col), d = *(const f32x4*)(Dt + (size_t)k * (NB * FW) + b * FW + col); v[j] = (c + d * sg) * isq; }
                ss += (v[j][0] * v[j][0] + v[j][1] * v[j][1]) + (v[j][2] * v[j][2] + v[j][3] * v[j][3]); }
            const float rstd = rsqrtf(wave_sum(ss) * (1.f / FW) + NORM_EPS);
#pragma unroll
            for (int j = 0; j < 8; ++j) { const int col = F.lane * 4 + 256 * j; const f32x4 g = *(const f32x4*)(g_fourier_out + col); const f32x4 o = v[j] * rstd * g;
                u32x2 w; w.x = cvt_pk_bf16(o[0], o[1]); w.y = cvt_pk_bf16(o[2], o[3]); *(u32x2*)(Y + (size_t)t * DM + col) = w; }
            u32x4 a[4]; float sa = 0.f;
#pragma unroll
            for (int j = 0; j < 4; ++j) { a[j] = *(const u32x4*)(yA + (size_t)t * FW + F.lane * 8 + 512 * j);
#pragma unroll
                for (int q = 0; q < 4; ++q) { const float x0 = bflo(a[j][q]), x1 = bfhi(a[j][q]); sa += x0 * x0 + x1 * x1; } }
            const float rsa = rsqrtf(wave_sum(sa) * (1.f / FW) + NORM_EPS);
#pragma unroll
            for (int j = 0; j < 4; ++j) { const int col = F.lane * 8 + 512 * j; const f32x4 g0 = *(const f32x4*)(g_mla_out + col), g1 = *(const f32x4*)(g_mla_out + col + 4);
                u32x4 w; w.x = cvt_pk_bf16(bflo(a[j].x) * rsa * g0[0], bfhi(a[j].x) * rsa * g0[1]); w.y = cvt_pk_bf16(bflo(a[j].y) * rsa * g0[2], bfhi(a[j].y) * rsa * g0[3]);
                w.z = cvt_pk_bf16(bflo(a[j].z) * rsa * g1[0], bfhi(a[j].z) * rsa * g1[1]); w.w = cvt_pk_bf16(bflo(a[j].w) * rsa * g1[2], bfhi(a[j].w) * rsa * g1[3]);
                *(u32x4*)(Y + (size_t)t * DM + FW + col) = w; }
        }
        SEAM(5);
    }
    if (IN(6)) {
        pg8::Order S; S.init(Y, DM, WoutT, DM, NTOK / 256, DM / 256, 1, 1, 0, 0, 0, 0, G, cid);
        pg8::EpiF32 E{hbuf, in_x, DM, 1.f, 0}; pg8::gemm_phase(F.lds, DM, DM, DM, S, E);
        SEAM(6);
    }
    if (IN(7)) { rms_rows(F, hbuf, g_xattn, XN, NTOK); SEAM(7); }
    if (IN(8)) {
        pg8::Order S; S.init(XN, DM, MT, DM, SEQ / 256, (XH * MEMT) / 256, NB, 1, (size_t)SEQ * DM * 2, 0, (size_t)XH * MEMT * DM * 2, 0, G, cid);
        pg8::EpiF32 E{SC, nullptr, XH * MEMT, 0.03125f, SEQ}; pg8::gemm_phase(F.lds, DM, DM, DM, S, E);
        SEAM(8);
    }
    if (IN(9)) {
        for (int t = F.gw; t < NTOK; t += F.ngw) {
#pragma unroll
            for (int h = 0; h < XH; ++h) { const f32x4 v = *(const f32x4*)(SC + (size_t)t * (XH * MEMT) + h * MEMT + F.lane * 4);
                const float mx = wave_max(fmaxf(fmaxf(v[0], v[1]), fmaxf(v[2], v[3])));
                const float e0 = __expf(v[0] - mx), e1 = __expf(v[1] - mx), e2 = __expf(v[2] - mx), e3 = __expf(v[3] - mx);
                const float inv = 1.f / wave_sum((e0 + e1) + (e2 + e3));
                u32x2 w; w.x = cvt_pk_bf16(e0 * inv, e1 * inv); w.y = cvt_pk_bf16(e2 * inv, e3 * inv);
                *(u32x2*)(Pb + (size_t)t * (XH * MEMT) + h * MEMT + F.lane * 4) = w; } }
        SEAM(9);
    }
    if (IN(10)) {
        pg8::Order S; S.init(Pb, XH * MEMT, NVT, XH * MEMT, SEQ / 256, DM / 256, NB, 1, (size_t)SEQ * XH * MEMT * 2, 0, (size_t)DM * XH * MEMT * 2, 0, G, cid);
        pg8::EpiF32 E{hbuf, hbuf, DM, 1.f, SEQ}; pg8::gemm_phase(F.lds, XH * MEMT, XH * MEMT, XH * MEMT, S, E);
        SEAM(10);
    }
    if (IN(11)) {
        rms_rows(F, hbuf, g_mlp, XN, NTOK);
        convert_transpose<0>(F, w_ff1, DM, DFF, W1T, 1.f);
        convert_transpose<0>(F, w_ff2, DFF, DM, W2T, 1.f);
        SEAM(11);
    }
    if (IN(12)) {
        pg8::Order S; S.init(XN, DM, W1T, DM, NTOK / 256, DFF / 256, 1, 1, 0, 0, 0, 0, G, cid);
        pg8::EpiBf16Lin<1> E{Abuf, DFF, 1, 0, 0, (size_t)256 * DFF, 256, 1.f}; pg8::gemm_phase(F.lds, DM, DM, DM, S, E);
        SEAM(12);
    }
    if (IN(13)) {
        pg8::Order S; S.init(Abuf, DFF, W2T, DFF, NTOK / 256, DM / 256, 1, 1, 0, 0, 0, 0, G, cid);
        pg8::EpiF32 E{hbuf, hbuf, DM, 1.f, 0}; pg8::gemm_phase(F.lds, DFF, DFF, DFF, S, E);
        SEAM(13);
    }
    if (IN(14)) {
        for (int m = F.gw; m < NTOK; m += F.ngw) rms_row4096<true>(hbuf + (size_t)m * DM, g_final, hbuf + (size_t)m * DM, F.lane);
    }
#undef IN
#undef SEAM
#undef GRID_BAR
}


struct DumpArgs { float* out; const unsigned char* ws; unsigned long long off[8]; unsigned long long n[8]; int isf32[8]; int nreg; int pad; };
__global__ void dump_k(DumpArgs d) {
    for (size_t i = (size_t)blockIdx.x * blockDim.x + threadIdx.x; i < (size_t)NTOK * DM; i += (size_t)gridDim.x * blockDim.x) {
        float acc = 0.f;
        for (int r = 0; r < d.nreg; ++r) { const size_t j = i % d.n[r];
            const float v = d.isf32[r] ? ((const float*)(d.ws + d.off[r]))[j] : bf2f(((const bf16_t*)(d.ws + d.off[r]))[j]);
            acc += v * (float)(r + 1); }
        d.out[i] = acc; }
}
extern "C" void kernel_launch(void* const* d_in, const int* in_sizes, int n_in, void* d_out, int out_size, void* d_ws, size_t ws_size, hipStream_t stream) {
    static int grid = 0;
    if (grid == 0) {
        if (n_in != 23 || in_sizes[0] != NTOK * DM || out_size != NTOK * DM || ws_size < WS_END) {
            fprintf(stderr, "kernel_launch: shape/workspace mismatch: n_in %d in0 %d out %d ws %zu (need >= %zu)\n", n_in, n_in > 0 ? in_sizes[0] : -1, out_size, ws_size, (size_t)WS_END); grid = -1; return; }
        int dev = 0, cus = 0, per_cu = 0;
        if (hipGetDevice(&dev) != hipSuccess || hipDeviceGetAttribute(&cus, hipDeviceAttributeMultiprocessorCount, dev) != hipSuccess) { fprintf(stderr, "kernel_launch: device query failed\n"); grid = -1; return; }
        if (hipFuncSetAttribute((const void*)mk_fwd, hipFuncAttributeMaxDynamicSharedMemorySize, LDS_BYTES) != hipSuccess) { fprintf(stderr, "kernel_launch: hipFuncSetAttribute failed\n"); grid = -1; return; }
        if (hipOccupancyMaxActiveBlocksPerMultiprocessor(&per_cu, (const void*)mk_fwd, NTHR, LDS_BYTES) != hipSuccess || per_cu < 1) {
            fprintf(stderr, "kernel_launch: occupancy query reports %d workgroups per CU\n", per_cu); }
        (void)hipGetLastError();
        grid = cus;
    }
    if (grid < 0) return;
    if (hipMemsetAsync((char*)d_ws + WS_CTL, 0, CTL_ZERO_BYTES, stream) != hipSuccess) { fprintf(stderr, "kernel_launch: memset failed\n"); return; }
    Args a{};
    for (int i = 0; i < 23; ++i) a.in[i] = d_in[i];
    a.out = (float*)d_out; a.ws = (unsigned char*)d_ws;
#if MK_PER_PHASE
#ifndef DBG_STOP
#define DBG_STOP N_PHASES
#endif
    for (int p = 0; p < DBG_STOP; ++p) { a.ph_lo = p; a.ph_hi = p + 1; hipLaunchKernelGGL(mk_fwd, dim3(grid), dim3(NTHR), LDS_BYTES, stream, a); }
#if defined(DBG_DUMP)
    { DumpArgs d{}; d.out = (float*)d_out; d.ws = (const unsigned char*)d_ws; int r = 0;
#define REG(o, cnt, f) do { d.off[r] = (o); d.n[r] = (cnt); d.isf32[r] = (f); ++r; } while (0)
#if DBG_STOP == 4
      REG(WS_TT, (size_t)4096 * 16384, 0); REG(WS_Q, (size_t)NTOK * 3072, 0); REG(WS_K, (size_t)NTOK * 3072, 0); REG(WS_V, (size_t)NTOK * 2048, 0); REG(WS_MT, (size_t)2 * 1024 * 4096, 0); REG(WS_NVT, (size_t)2 * 1024 * 4096, 0);
#elif DBG_STOP == 2
      REG(WS_ZF, (size_t)NTOK * 2048, 0); REG(WS_CQ, (size_t)NTOK * 1024, 0); REG(WS_CKV, (size_t)NTOK * 512, 0); REG(WS_KROPE, (size_t)NTOK * 64, 0); REG(WS_KX, (size_t)512 * 8192, 0);
#elif DBG_STOP == 1
      REG(WS_XN, (size_t)NTOK * 4096, 0); REG(WS_MEMN, (size_t)512 * 4096, 0); REG(WS_WINT, (size_t)3840 * 4096, 0); REG(WS_WXKT, (size_t)8192 * 4096, 0); REG(WS_WUQT, (size_t)3072 * 1024, 0); REG(WS_WUKVT, (size_t)4096 * 512, 0); REG(WS_MGT, (size_t)8 * 512 * 256, 0); REG(WS_CS, (size_t)8192 * 8192, 0);
#elif DBG_STOP == 5
      REG(WS_SS, (size_t)4096 * 8192, 0);
#elif DBG_STOP == 6
      REG(WS_Y, (size_t)NTOK * 4096, 0);
#endif
      d.nreg = r; hipLaunchKernelGGL(dump_k, dim3(4096), dim3(256), 0, stream, d); }
#endif
#else
    a.ph_lo = 0; a.ph_hi = N_PHASES; hipLaunchKernelGGL(mk_fwd, dim3(grid), dim3(NTHR), LDS_BYTES, stream, a);
#endif
    const hipError_t le = hipPeekAtLastError();
    if (le != hipSuccess) fprintf(stderr, "kernel_launch: launch failed: %s\n", hipGetErrorName(le));
}
```

```cpp
#define REP_MASK 0x0
#include <hip/hip_runtime.h>
#include <cstdio>
#include <cstdint>

#ifndef MK_PER_PHASE
#define MK_PER_PHASE 0
#endif

#define LAS __attribute__((address_space(3)))
#define GAS __attribute__((address_space(1)))
typedef unsigned short bf16_t;
typedef short bf16x8 __attribute__((ext_vector_type(8)));
typedef short s16x4 __attribute__((ext_vector_type(4)));
typedef float f32x2 __attribute__((ext_vector_type(2)));
typedef float f32x4 __attribute__((ext_vector_type(4)));
typedef float f32x16 __attribute__((ext_vector_type(16)));
typedef unsigned u32x2 __attribute__((ext_vector_type(2)));
typedef unsigned u32x4 __attribute__((ext_vector_type(4)));

constexpr int DM = 4096, NB = 2, SEQ = 8192, NTOK = NB * SEQ;
constexpr int FW = 2048, FG = 8, FC = 256;
constexpr int NH = 16, DNOPE = 128, DROPE = 64, DV = 128, DQK = 192;
constexpr int QR = 1024, KVR = 512, INW = 3648, INWP = 3840;
constexpr int MEMT = 256, XH = 4, XHD = 1024;
constexpr int DFF = 16384;
constexpr float NORM_EPS = 1e-6f;
constexpr int NWAVES = 8, NTHR = 512;

constexpr size_t MiB = 1ull << 20;
constexpr size_t WS_CTL = 0, CTL_ZERO_BYTES = 512 * 1024, WS_SSQ1 = 64 * 1024, WS_SSQ2 = 128 * 1024, WS_SSQQ = 192 * 1024, WS_SSQKV = 256 * 1024, WS_RSTDX = 320 * 1024;
constexpr size_t WS_ROPEC = 1 * MiB, WS_ROPES = 3 * MiB, WS_Y4096 = 5 * MiB, WS_MEMN = 6 * MiB, WS_KX = 10 * MiB, WS_VX = 14 * MiB;
constexpr size_t WS_WUQT = 18 * MiB, WS_WUKVT = 24 * MiB, WS_MGT = 28 * MiB, WS_MT = 30 * MiB, WS_NVT = 46 * MiB;
constexpr size_t WS_XN = 64 * MiB, WS_TT = 64 * MiB, WS_ZE = 128 * MiB, WS_ZO = 160 * MiB;
constexpr size_t WS_TR4096 = 5 * MiB + 65536;
constexpr size_t WS_CS = 192 * MiB, WS_SS = 224 * MiB, WS_Y = 192 * MiB, WS_A = 192 * MiB;
constexpr size_t WS_ZF = 320 * MiB, WS_CQ = 384 * MiB, WS_CKV = 416 * MiB, WS_KROPE = 432 * MiB, WS_CT = 320 * MiB, WS_DT = 384 * MiB;
constexpr size_t WS_WINT = 448 * MiB, WS_WXKT = 480 * MiB, WS_WXVT = 512 * MiB, WS_Q = 448 * MiB, WS_K = 544 * MiB, WS_V = 640 * MiB;
constexpr size_t WS_YA = 704 * MiB, WS_SC = 704 * MiB, WS_WOUTT = 768 * MiB, WS_P = 800 * MiB, WS_WXQ = 832 * MiB, WS_WXOT = 864 * MiB;
constexpr size_t WS_W1T = 704 * MiB, WS_W2T = 832 * MiB, WS_END = 960 * MiB;
constexpr int CW_BAR = 4096;

constexpr int RING_BYTES = 131072;
constexpr int MISC_OFF = RING_BYTES;
constexpr int LDS_BYTES = RING_BYTES + 1024 + 8192;

typedef __bf16 bf16x2_t __attribute__((ext_vector_type(2)));
__device__ __forceinline__ unsigned cvt_pk_bf16(float lo, float hi) { const f32x2 v = {lo, hi}; const bf16x2_t r = __builtin_convertvector(v, bf16x2_t); return __builtin_bit_cast(unsigned, r); }
__device__ __forceinline__ u32x2 cvt_pk8_fp8(f32x4 a, f32x4 b) { unsigned w0 = 0u, w1 = 0u;
    w0 = __builtin_amdgcn_cvt_pk_fp8_f32(a[0], a[1], w0, false); w0 = __builtin_amdgcn_cvt_pk_fp8_f32(a[2], a[3], w0, true);
    w1 = __builtin_amdgcn_cvt_pk_fp8_f32(b[0], b[1], w1, false); w1 = __builtin_amdgcn_cvt_pk_fp8_f32(b[2], b[3], w1, true); return (u32x2){w0, w1}; }
__device__ __forceinline__ float bf2f(unsigned short b) { return __uint_as_float(((unsigned)b) << 16); }
__device__ __forceinline__ float bflo(unsigned w) { return __uint_as_float(w << 16); }
__device__ __forceinline__ float bfhi(unsigned w) { return __uint_as_float(w & 0xffff0000u); }
__device__ __forceinline__ float wave_sum(float v) {
#pragma unroll
    for (int o = 1; o < 64; o <<= 1) v += __shfl_xor(v, o);
    return v;
}
__device__ __forceinline__ float wave_max(float v) {
#pragma unroll
    for (int o = 1; o < 64; o <<= 1) v = fmaxf(v, __shfl_xor(v, o));
    return v;
}
#define LDS_WAIT() asm volatile("s_waitcnt lgkmcnt(0)" ::: "memory")
#define VM_WAIT() asm volatile("s_waitcnt vmcnt(0)" ::: "memory")

#define XB_TMO      128
#define XB_XCNT(j)  (256  + 64 * (j))
#define XB_XSUB(j)  (1280 + 64 * (j))
#define XB_XGEN(j)  (2304 + 64 * (j))
#define XB_TOP      3328
#define XB_TOPGEN   3392
#define XCD_BAR_WORDS 3456
#define XB_SPIN_CAP (1u << 18)
__device__ __forceinline__ unsigned xb_ld(unsigned* p)              { return __hip_atomic_load(p, __ATOMIC_RELAXED, __HIP_MEMORY_SCOPE_AGENT); }
__device__ __forceinline__ unsigned xb_add(unsigned* p, unsigned v) { return __hip_atomic_fetch_add(p, v, __ATOMIC_RELAXED, __HIP_MEMORY_SCOPE_AGENT); }
__device__ __forceinline__ unsigned xb_xcc_id() { return (unsigned)__builtin_amdgcn_s_getreg((3 << 11) | 20) & 0xFu; }
#define XB_SPIN(cond, bar) do { unsigned _sp = 0; while (cond) { __builtin_amdgcn_s_sleep(1); \
    if ((++_sp & 255u) == 0u) { if (xb_ld(&(bar)[XB_TMO])) break; if (_sp > XB_SPIN_CAP) { atomicAdd(&(bar)[XB_TMO], 1u); break; } } } } while (0)
struct XcdBarrier { unsigned* bar; unsigned x; volatile LAS unsigned* st; };
__device__ __forceinline__ XcdBarrier xcd_barrier_post(unsigned* bar, volatile LAS unsigned* st) {
    XcdBarrier b; b.bar = bar; b.x = xb_xcc_id(); b.st = st;
    if (threadIdx.x == 0) (void)xb_add(&bar[XB_XCNT(b.x)], 1u);
    return b;
}
__device__ __forceinline__ void xcd_barrier_complete(unsigned* bar, unsigned x, unsigned& nloc, unsigned& nx) {
    const unsigned G = gridDim.x * gridDim.y * gridDim.z;
    unsigned sum, cnt, mine, sp = 0u;
    for (;;) {
        sum = 0u; cnt = 0u; mine = 0u;
#pragma unroll
        for (unsigned j = 0; j < 16; ++j) { const unsigned c = xb_ld(&bar[XB_XCNT(j)]); sum += c; cnt += (c > 0u) ? 1u : 0u; mine = (j == x) ? c : mine; }
        if (sum == G) break;
        __builtin_amdgcn_s_sleep(1);
        if ((++sp & 255u) == 0u) { if (xb_ld(&bar[XB_TMO])) break; if (sp > XB_SPIN_CAP) { atomicAdd(&bar[XB_TMO], 1u); break; } }
    }
    nloc = mine > 0u ? mine : 1u; nx = cnt > 0u ? cnt : 1u;
}
__device__ __forceinline__ void xcd_barrier(const XcdBarrier& b) {
    asm volatile("s_waitcnt vmcnt(0)" ::: "memory");
    __syncthreads();
    if (threadIdx.x == 0) {
        unsigned* bar = b.bar;
        __builtin_amdgcn_s_waitcnt(0);
        unsigned nloc = b.st[0], nx = b.st[1];
        if (nloc == 0u) { xcd_barrier_complete(bar, b.x, nloc, nx); b.st[0] = nloc; b.st[1] = nx; }
        const unsigned old = xb_add(&bar[XB_XSUB(b.x)], 1u);
        const unsigned gen = old / nloc;
        if (old + 1u == (gen + 1u) * nloc) {
            __builtin_amdgcn_fence(__ATOMIC_RELEASE, "agent");
            asm volatile("s_waitcnt vmcnt(0)" ::: "memory");
            const unsigned og = xb_add(&bar[XB_TOP], 1u);
            const unsigned tg = og / nx;
            if (og + 1u == (tg + 1u) * nx) xb_add(&bar[XB_TOPGEN], 1u);
            else XB_SPIN(xb_ld(&bar[XB_TOPGEN]) == tg, bar);
            __builtin_amdgcn_fence(__ATOMIC_ACQUIRE, "agent");
            xb_add(&bar[XB_XGEN(b.x)], 1u);
            asm volatile("s_waitcnt vmcnt(0)" ::: "memory");
        } else {
            XB_SPIN(xb_ld(&bar[XB_XGEN(b.x)]) == gen, bar);
            __builtin_amdgcn_fence(__ATOMIC_ACQUIRE, "agent");
            asm volatile("s_waitcnt vmcnt(0)" ::: "memory");
        }
    }
    __syncthreads();
}

namespace pg8 {
constexpr int BM = 256, BK = 64, HALF = 128, HTB = HALF * BK * 2, STAGE_BYTES = 8 * HTB, NXCD = 8, WGM = 8;
__device__ __forceinline__ int lds_byte(int r, int c) { const int st = (r >> 4) * 2 + (c >> 5), rr = r & 15, cc = c & 31, ob = rr * 64 + cc * 2; return st * 1024 + (ob ^ (((ob >> 9) & 1) << 5)); }
__device__ __forceinline__ void stage_rc(int b, int& R, int& C) { const int st = b / 1024, sb = b % 1024, swz = sb ^ (((sb >> 9) & 1) << 5); R = (st >> 1) * 16 + swz / 64; C = (st & 1) * 32 + (swz % 64) / 2; }
__device__ __forceinline__ int perm32(int rho) { const int n = rho >> 4, i = rho & 15; return 8 * (i >> 2) + 4 * n + (i & 3); }

struct Unit { int pm, pn, z; };
struct Order {
    int nM, nN, nZ2, per, nwg, G, c;
    const char* A; const char* Bt; size_t tA, tB, zA1, zA2, zB1, zB2, pmB;
    __device__ __forceinline__ void init(const void* A_, int lda, const void* Bt_, int ldb, int nM_, int nN_, int nZ1, int nZ2_,
                                         size_t zA1_, size_t zA2_, size_t zB1_, size_t zB2_, int G_, int c_) {
        A = (const char*)A_; Bt = (const char*)Bt_; nM = nM_; nN = nN_; nZ2 = nZ2_; per = nM_ * nN_; nwg = per * nZ1 * nZ2_; G = G_; c = c_;
        tA = (size_t)BM * lda * 2; tB = (size_t)BM * ldb * 2; zA1 = zA1_; zA2 = zA2_; zB1 = zB1_; zB2 = zB2_; pmB = 0;
    }
    __device__ __forceinline__ bool next(int i, Unit& u) const {
        const long L = (long)i * G + c; if (c < 0 || L >= nwg) return false;
        int wgid = (int)L; { const int q = nwg / NXCD, r = nwg % NXCD, xcd = wgid % NXCD, off = wgid / NXCD; wgid = (xcd < r ? xcd * (q + 1) : r * (q + 1) + (xcd - r) * q) + off; }
        u.z = wgid / per; const int w = wgid - u.z * per;
        const int nig = WGM * nN, gid = w / nig, fm = gid * WGM, gsz = (nM - fm) < WGM ? (nM - fm) : WGM;
        u.pm = fm + ((w % nig) % gsz); u.pn = (w % nig) / gsz; return true;
    }
    __device__ __forceinline__ const char* aptr(const Unit& u) const { return A + (size_t)(u.z / nZ2) * zA1 + (size_t)(u.z % nZ2) * zA2 + (size_t)u.pm * tA; }
    __device__ __forceinline__ const char* bptr(const Unit& u) const { return Bt + (size_t)(u.z / nZ2) * zB1 + (size_t)(u.z % nZ2) * zB2 + (size_t)u.pn * tB + (size_t)u.pm * pmB; }
};

template <int MODE = 0, class Epi>
__device__ __forceinline__ void gemm_phase(LAS unsigned char* lds, const int K, const int lda, const int ldb, const Order& S, const Epi& E) {
    constexpr bool F8 = (MODE == 1), I8 = (MODE == 2);
    const int tid = threadIdx.x, wid = __builtin_amdgcn_readfirstlane(tid >> 6), lane = tid & 63, wr = wid >> 2, wc = wid & 3, fr = lane & 15, fq = lane >> 4;
    const int nt = K / BK;
    unsigned voffA[2], voffB[2];
#pragma unroll
    for (int i = 0; i < 2; ++i) { int R, C; stage_rc(tid * 16 + i * 8192, R, C); const int Rb = Epi::PERM ? ((R & ~31) + perm32(R & 31)) : R;
        voffA[i] = (unsigned)(R * lda + C) * 2u; voffB[i] = (unsigned)(Rb * ldb + C) * 2u; }
    const size_t kstep = (size_t)(BK * 2);
    const size_t hstepA = (size_t)HALF * lda * 2, hstepB = (size_t)HALF * ldb * 2;
    const unsigned ldsw = (unsigned)wid * 1024u;
    const int f8in = (((fr * 64) + (fq & 1) * 32) ^ ((fr >> 3) << 5)) + (fq >> 1) * 1024;
    const int aoff = F8 ? wr * 8192 + f8in : lds_byte(wr * 64 + fr, fq * 8), boff = F8 ? wc * 4096 + f8in : lds_byte(wc * 32 + fr, fq * 8);
    constexpr int KCH = F8 ? 16 : 1024;
#define PG8_SA(b, h) (((b) * 2 + (h)) * HTB)
#define PG8_SB(b, h) ((4 + (b) * 2 + (h)) * HTB)
#define PG8_STAGE(bufoff, gbase, voff) do { _Pragma("unroll") for (int _i = 0; _i < 2; ++_i) \
        __builtin_amdgcn_global_load_lds((const unsigned*)((const char*)(gbase) + (voff)[_i]), (LAS unsigned*)(lds + (bufoff) + ldsw + _i * 8192), 16, 0, 0); } while (0)
#define PG8_LDA(dst, b, h) do { _Pragma("unroll") for (int m = 0; m < 4; ++m) _Pragma("unroll") for (int k = 0; k < 2; ++k) dst[m][k] = *(const LAS bf16x8*)(lds + PG8_SA(b, h) + aoff + m * 2048 + k * KCH); } while (0)
#define PG8_LDB(dst, b, h) do { _Pragma("unroll") for (int n = 0; n < 2; ++n) _Pragma("unroll") for (int k = 0; k < 2; ++k) dst[n][k] = *(const LAS bf16x8*)(lds + PG8_SB(b, h) + boff + n * 2048 + k * KCH); } while (0)
#define PG8_MMA(ai, bj, At, Bt) do { __builtin_amdgcn_s_setprio(1); _Pragma("unroll") for (int m = 0; m < 4; ++m) _Pragma("unroll") for (int n = 0; n < 2; ++n) { \
        if constexpr (F8) { typedef int v4i_ __attribute__((ext_vector_type(4))); typedef int v8i_ __attribute__((ext_vector_type(8))); \
            const v8i_ a8_ = __builtin_shufflevector(__builtin_bit_cast(v4i_, At[m][0]), __builtin_bit_cast(v4i_, At[m][1]), 0, 1, 2, 3, 4, 5, 6, 7); \
            const v8i_ b8_ = __builtin_shufflevector(__builtin_bit_cast(v4i_, Bt[n][0]), __builtin_bit_cast(v4i_, Bt[n][1]), 0, 1, 2, 3, 4, 5, 6, 7); \
            asm volatile("v_mfma_f32_16x16x128_f8f6f4 %0, %1, %2, %0" : "+v"(acc[ai][bj][m][n]) : "v"(b8_), "v"(a8_)); }   \
        else if constexpr (I8) { typedef int v4i_ __attribute__((ext_vector_type(4))); _Pragma("unroll") for (int k = 0; k < 2; ++k) \
            acc[ai][bj][m][n] = __builtin_bit_cast(f32x4, __builtin_amdgcn_mfma_i32_16x16x64_i8(__builtin_bit_cast(v4i_, Bt[n][k]), __builtin_bit_cast(v4i_, At[m][k]), __builtin_bit_cast(v4i_, acc[ai][bj][m][n]), 0, 0, 0)); } \
        else { _Pragma("unroll") for (int k = 0; k < 2; ++k) acc[ai][bj][m][n] = __builtin_amdgcn_mfma_f32_16x16x32_bf16(Bt[n][k], At[m][k], acc[ai][bj][m][n], 0, 0, 0); } } \
        __builtin_amdgcn_s_setprio(0); } while (0)
#define PG8_WAIT_V(n) asm volatile("s_waitcnt vmcnt(" #n ")" ::: "memory")
#define PG8_WAIT_L(n) asm volatile("s_waitcnt lgkmcnt(" #n ")" ::: "memory")
#define PG8_BAR __builtin_amdgcn_s_barrier()
#define PG8_SCHED __builtin_amdgcn_sched_barrier(0)
    Unit cur, nxt; int ui = 0;
    if (!S.next(0, cur)) return;
    f32x4 acc[2][2][4][2];
#pragma unroll
    for (int a = 0; a < 2; ++a)
#pragma unroll
        for (int b = 0; b < 2; ++b)
#pragma unroll
            for (int m = 0; m < 4; ++m)
#pragma unroll
                for (int n = 0; n < 2; ++n) acc[a][b][m][n] = (f32x4){0.f, 0.f, 0.f, 0.f};
    bf16x8 At[4][2], B0[2][2], B1[2][2];
    const char* cA = S.aptr(cur); const char* cB = S.bptr(cur);
    PG8_STAGE(PG8_SB(0, 0), cB, voffB); PG8_STAGE(PG8_SB(0, 1), cB + hstepB, voffB); PG8_STAGE(PG8_SA(0, 0), cA, voffA); PG8_STAGE(PG8_SA(0, 1), cA + hstepA, voffA);
    if (wr == 1) PG8_BAR;
    PG8_WAIT_V(2); PG8_BAR;
    PG8_STAGE(PG8_SB(1, 0), cB + kstep, voffB); PG8_STAGE(PG8_SA(1, 0), cA + kstep, voffA); PG8_STAGE(PG8_SB(1, 1), cB + hstepB + kstep, voffB);
    PG8_WAIT_V(6); PG8_BAR;
    for (;;) {
        const bool has_next = S.next(ui + 1, nxt);
        const char* nA = has_next ? S.aptr(nxt) : cA; const char* nB = has_next ? S.bptr(nxt) : cB;
#pragma unroll 1
        for (int t = 0; t < nt; t += 2) {
            const bool last = (t == nt - 2);
            const char* a1 = cA + (size_t)(t + 1) * kstep;
            const char* a2 = last ? nA : cA + (size_t)(t + 2) * kstep; const char* b2 = last ? nB : cB + (size_t)(t + 2) * kstep;
            const char* a3 = a2 + kstep; const char* b3 = b2 + kstep;
            PG8_LDB(B0, 0, 0); PG8_LDB(B1, 0, 1); PG8_SCHED; PG8_LDA(At, 0, 0); PG8_STAGE(PG8_SA(1, 1), a1 + hstepA, voffA);
            PG8_WAIT_V(8); PG8_WAIT_L(0); PG8_BAR; PG8_MMA(0, 0, At, B0); PG8_MMA(0, 1, At, B1); PG8_BAR; PG8_SCHED;
            PG8_LDA(At, 0, 1); PG8_STAGE(PG8_SB(0, 0), b2, voffB); PG8_STAGE(PG8_SB(0, 1), b2 + hstepB, voffB); PG8_STAGE(PG8_SA(0, 0), a2, voffA);
            PG8_WAIT_V(8); PG8_WAIT_L(0); PG8_BAR; PG8_MMA(1, 0, At, B0); PG8_MMA(1, 1, At, B1); PG8_BAR; PG8_SCHED;
            PG8_LDB(B0, 1, 0); PG8_LDB(B1, 1, 1); PG8_SCHED; PG8_LDA(At, 1, 0); PG8_STAGE(PG8_SA(0, 1), a2 + hstepA, voffA);
            PG8_WAIT_V(8); PG8_WAIT_L(0); PG8_BAR; PG8_MMA(0, 0, At, B0); PG8_MMA(0, 1, At, B1); PG8_BAR; PG8_SCHED;
            PG8_LDA(At, 1, 1); PG8_STAGE(PG8_SB(1, 0), b3, voffB); PG8_STAGE(PG8_SB(1, 1), b3 + hstepB, voffB); PG8_STAGE(PG8_SA(1, 0), a3, voffA);
            PG8_WAIT_V(8); PG8_WAIT_L(0); PG8_BAR; PG8_MMA(1, 0, At, B0); PG8_MMA(1, 1, At, B1); PG8_BAR; PG8_SCHED;
        }
        if constexpr (F8) { asm volatile("s_nop 15\n\ts_nop 15"); PG8_SCHED; }
        if constexpr (I8) { typedef int v4i_ __attribute__((ext_vector_type(4)));
#pragma unroll
            for (int a = 0; a < 2; ++a)
#pragma unroll
                for (int b = 0; b < 2; ++b)
#pragma unroll
                    for (int m = 0; m < 4; ++m)
#pragma unroll
                        for (int n = 0; n < 2; ++n) acc[a][b][m][n] = __builtin_convertvector(__builtin_bit_cast(v4i_, acc[a][b][m][n]), f32x4); }
        if (wr == 0) PG8_BAR;
        E(acc, cur, wr, wc, fr, fq);
        if (!has_next) break;
#pragma unroll
        for (int a = 0; a < 2; ++a)
#pragma unroll
            for (int b = 0; b < 2; ++b)
#pragma unroll
                for (int m = 0; m < 4; ++m)
#pragma unroll
                    for (int n = 0; n < 2; ++n) acc[a][b][m][n] = (f32x4){0.f, 0.f, 0.f, 0.f};
        cur = nxt; cA = nA; cB = nB; ++ui;
        if (wr == 1) PG8_BAR;
    }
    PG8_WAIT_V(0);
    PG8_BAR;
#undef PG8_SA
#undef PG8_SB
#undef PG8_STAGE
#undef PG8_LDA
#undef PG8_LDB
#undef PG8_MMA
#undef PG8_WAIT_V
#undef PG8_WAIT_L
#undef PG8_BAR
#undef PG8_SCHED
}

template <int ACT>
__device__ __forceinline__ void store_tile_bf16(const f32x4 (&acc)[2][2][4][2], bf16_t* p0, bf16_t* p1, int ld0, int ld1, int nv0, int nv1, float scale, int wr, int wc, int fr, int fq, const float* rs = nullptr  ) {
#pragma unroll
    for (int bj = 0; bj < 2; ++bj) {
        bf16_t* p = bj ? p1 : p0; const int ld = bj ? ld1 : ld0, nv = bj ? nv1 : nv0;
        if (p == nullptr || wc * 32 >= nv) continue;
#pragma unroll
        for (int ai = 0; ai < 2; ++ai)
#pragma unroll
            for (int m = 0; m < 4; ++m) {
                const int row = ai * HALF + wr * 64 + m * 16 + fr;
                const float sc_ = rs ? scale * rs[ai * 4 + m] : scale;
                f32x4 v0 = acc[ai][bj][m][0] * sc_, v1 = acc[ai][bj][m][1] * sc_;
                if (ACT == 1) {
#pragma unroll
                    for (int j = 0; j < 4; ++j) { const float a = fmaxf(v0[j], 0.f), b = fmaxf(v1[j], 0.f); v0[j] = a * a; v1[j] = b * b; } }
                u32x4 w; w.x = cvt_pk_bf16(v0[0], v0[1]); w.y = cvt_pk_bf16(v0[2], v0[3]); w.z = cvt_pk_bf16(v1[0], v1[1]); w.w = cvt_pk_bf16(v1[2], v1[3]);
                *(u32x4*)(p + (size_t)row * ld + wc * 32 + 8 * fq) = w;
            }
    }
}
struct EpiInProj {
    static constexpr bool PERM = true;
    bf16_t *zf, *cq, *ckv, *kr; const float* rstdx; float *ssq_q, *ssq_kv;
    __device__ __forceinline__ void operator()(const f32x4 (&acc)[2][2][4][2], const Unit& u, int wr, int wc, int fr, int fq) const {
        asm volatile("" : "+v"(fr), "+v"(fq));
        const size_t r0 = (size_t)u.pm * BM; bf16_t *p0, *p1; int ld, nv0 = 128, nv1 = 128;
        if (u.pn < 8)       { ld = FW;  p0 = zf + r0 * FW + u.pn * 256; p1 = p0 + 128; }
        else if (u.pn < 12) { ld = QR;  p0 = cq + r0 * QR + (u.pn - 8) * 256; p1 = p0 + 128; }
        else if (u.pn < 14) { ld = KVR; p0 = ckv + r0 * KVR + (u.pn - 12) * 256; p1 = p0 + 128; }
        else                { ld = DROPE; p0 = kr + r0 * DROPE; p1 = nullptr; nv0 = 64; nv1 = 0; }
        float rs[8];
#pragma unroll
        for (int ai = 0; ai < 2; ++ai)
#pragma unroll
            for (int m = 0; m < 4; ++m) rs[ai * 4 + m] = rstdx[r0 + ai * HALF + wr * 64 + m * 16 + fr];
        store_tile_bf16<0>(acc, p0, p1, ld, ld, nv0, nv1, 1.f, wr, wc, fr, fq, rs);
    }
};
template <int ACT>
struct EpiBf16Lin {
    static constexpr bool PERM = true;
    bf16_t* out; int ld, nZ2; size_t sz1, sz2, spm, spn; float scale;
    __device__ __forceinline__ void operator()(const f32x4 (&acc)[2][2][4][2], const Unit& u, int wr, int wc, int fr, int fq) const {
        asm volatile("" : "+v"(fr), "+v"(fq));
        bf16_t* p0 = out + (size_t)(u.z / nZ2) * sz1 + (size_t)(u.z % nZ2) * sz2 + (size_t)u.pm * spm + (size_t)u.pn * spn;
        store_tile_bf16<ACT>(acc, p0, p0 + 128, ld, ld, 128, 128, scale, wr, wc, fr, fq);
    }
};
struct EpiQ {
    static constexpr bool PERM = true;
    bf16_t* Q; const float* rc; const float* rs; const float* ssq;
    __device__ __forceinline__ void operator()(const f32x4 (&acc)[2][2][4][2], const Unit& u, int wr, int wc, int fr, int fq) const {
        asm volatile("" : "+v"(fr), "+v"(fq));
        const int colb = u.pn * 256 + wc * 32 + 8 * fq;
#pragma unroll
        for (int ai = 0; ai < 2; ++ai)
#pragma unroll
            for (int m = 0; m < 4; ++m) {
                const int row = u.pm * BM + ai * HALF + wr * 64 + m * 16 + fr; const float rq = 1.f;
#pragma unroll
                for (int bj = 0; bj < 2; ++bj) {
                    const int col = colb + bj * 128, w = col % DQK;
                    f32x4 v0 = acc[ai][bj][m][0] * rq, v1 = acc[ai][bj][m][1] * rq;
                    if (w >= DNOPE) {
                        const int p0 = (w - DNOPE) >> 1;
                        const f32x4 c = *(const f32x4*)(rc + (size_t)row * 32 + p0), s = *(const f32x4*)(rs + (size_t)row * 32 + p0);
                        const f32x4 a0 = v0, a1 = v1;
                        v0[0] = a0[0] * c[0] - a0[1] * s[0]; v0[1] = a0[0] * s[0] + a0[1] * c[0];
                        v0[2] = a0[2] * c[1] - a0[3] * s[1]; v0[3] = a0[2] * s[1] + a0[3] * c[1];
                        v1[0] = a1[0] * c[2] - a1[1] * s[2]; v1[1] = a1[0] * s[2] + a1[1] * c[2];
                        v1[2] = a1[2] * c[3] - a1[3] * s[3]; v1[3] = a1[2] * s[3] + a1[3] * c[3];
                    }
                    u32x4 o; o.x = cvt_pk_bf16(v0[0], v0[1]); o.y = cvt_pk_bf16(v0[2], v0[3]); o.z = cvt_pk_bf16(v1[0], v1[1]); o.w = cvt_pk_bf16(v1[2], v1[3]);
                    *(u32x4*)(Q + (size_t)row * (NH * DQK) + col) = o;
                }
                asm volatile("" ::: "memory");
            }
    }
};
struct EpiKV8 {
    static constexpr bool PERM = true;
    signed char* K8p; float* k8sp; bf16_t* Vb; const unsigned* krr; const float* krmax; LAS float* tab;
    __device__ __forceinline__ void operator()(const f32x4 (&acc)[2][2][4][2], const Unit& u, int wr, int wc, int fr, int fq) const {
        asm volatile("" : "+v"(fr), "+v"(fq));
        const size_t r0 = (size_t)u.pm * BM; const int h = u.pn; float bm[2][2];
#pragma unroll
        for (int ai = 0; ai < 2; ++ai)
#pragma unroll
            for (int mp = 0; mp < 2; ++mp) { float mx = 0.f;
#pragma unroll
                for (int mm = 0; mm < 2; ++mm) { const int m = 2 * mp + mm; mx = fmaxf(mx, krmax[r0 + ai * HALF + wr * 64 + m * 16 + fr]);
#pragma unroll
                    for (int n = 0; n < 2; ++n) { const f32x4 v = acc[ai][0][m][n]; mx = fmaxf(mx, fmaxf(fmaxf(fabsf(v[0]), fabsf(v[1])), fmaxf(fabsf(v[2]), fabsf(v[3])))); } }
#pragma unroll
                for (int o = 32; o > 0; o >>= 1) mx = fmaxf(mx, __shfl_xor(mx, o));
                if (fr == 0 && fq == 0) tab[((wr * 2 + ai) * 2 + mp) * 4 + wc] = mx; }
        asm volatile("s_waitcnt lgkmcnt(0)" ::: "memory"); __builtin_amdgcn_s_barrier(); asm volatile("" ::: "memory");
#pragma unroll
        for (int ai = 0; ai < 2; ++ai)
#pragma unroll
            for (int mp = 0; mp < 2; ++mp) { const f32x4 t4 = *(LAS const f32x4*)(tab + ((wr * 2 + ai) * 2 + mp) * 4); bm[ai][mp] = fmaxf(fmaxf(t4[0], t4[1]), fmaxf(t4[2], t4[3])); }
#pragma unroll
        for (int ai = 0; ai < 2; ++ai)
#pragma unroll
            for (int m = 0; m < 4; ++m) { const size_t t = r0 + ai * HALF + wr * 64 + m * 16 + fr; const int b = (int)(t / SEQ), sp = (int)(t % SEQ); const float mx = bm[ai][m >> 1], isc = mx > 0.f ? 127.f / mx : 0.f;
                signed char* kr = K8p + ((size_t)(b * NH + h) * SEQ + sp) * DQK;
                if (wc == 0 && fq == 0 && (m & 1) == 0 && fr == 0) k8sp[((size_t)(b * NH + h) * SEQ + sp) >> 5] = mx * (1.f / 127.f);
                const f32x4 v0 = acc[ai][0][m][0] * isc, v1 = acc[ai][0][m][1] * isc; u32x2 o;
                o.x = (unsigned)(((int)__builtin_rintf(v0[0]) & 0xff) | (((int)__builtin_rintf(v0[1]) & 0xff) << 8) | (((int)__builtin_rintf(v0[2]) & 0xff) << 16) | ((int)__builtin_rintf(v0[3]) << 24));
                o.y = (unsigned)(((int)__builtin_rintf(v1[0]) & 0xff) | (((int)__builtin_rintf(v1[1]) & 0xff) << 8) | (((int)__builtin_rintf(v1[2]) & 0xff) << 16) | ((int)__builtin_rintf(v1[3]) << 24));
                *(u32x2*)(kr + wc * 32 + 8 * fq) = o;
                const u32x2 rw = *(const u32x2*)(krr + t * 32 + wc * 8 + fq * 2);
                const unsigned q = (unsigned)(((int)__builtin_rintf(bflo(rw.x) * isc) & 0xff) | (((int)__builtin_rintf(bfhi(rw.x) * isc) & 0xff) << 8) | (((int)__builtin_rintf(bflo(rw.y) * isc) & 0xff) << 16) | ((int)__builtin_rintf(bfhi(rw.y) * isc) << 24));
                *(unsigned*)(kr + DNOPE + wc * 16 + fq * 4) = q; }
        store_tile_bf16<0>(acc, nullptr, Vb + r0 * (NH * DV) + u.pn * DV, NH * DQK, NH * DV, 128, 128, 1.f, wr, wc, fr, fq);
    }
};
struct EpiKV {
    static constexpr bool PERM = true;
    bf16_t *Kb, *Vb; const float* ssq;
    __device__ __forceinline__ void operator()(const f32x4 (&acc)[2][2][4][2], const Unit& u, int wr, int wc, int fr, int fq) const {
        asm volatile("" : "+v"(fr), "+v"(fq));
        const size_t r0 = (size_t)u.pm * BM; float rs[8];
#pragma unroll
        for (int ai = 0; ai < 2; ++ai)
#pragma unroll
            for (int m = 0; m < 4; ++m) rs[ai * 4 + m] = 1.f;
        store_tile_bf16<0>(acc, Kb + r0 * (NH * DQK) + u.pn * DQK, Vb + r0 * (NH * DV) + u.pn * DV, NH * DQK, NH * DV, 128, 128, 1.f, wr, wc, fr, fq, rs);
    }
};

struct EpiBf16ColGain {
    static constexpr bool PERM = true;
    bf16_t* out; const float* cg; int ld, nZ2; size_t sz1, sz2, spm, spn;
    __device__ __forceinline__ void operator()(const f32x4 (&acc)[2][2][4][2], const Unit& u, int wr, int wc, int fr, int fq) const {
        asm volatile("" : "+v"(fr), "+v"(fq));
        bf16_t* p0 = out + (size_t)(u.z / nZ2) * sz1 + (size_t)(u.z % nZ2) * sz2 + (size_t)u.pm * spm + (size_t)u.pn * spn;
#pragma unroll
        for (int bj = 0; bj < 2; ++bj) { const int colt = bj * 128 + wc * 32 + 8 * fq; const f32x4 g0 = *(const f32x4*)(cg + u.pn * 256 + colt), g1 = *(const f32x4*)(cg + u.pn * 256 + colt + 4);
#pragma unroll
            for (int ai = 0; ai < 2; ++ai)
#pragma unroll
                for (int m = 0; m < 4; ++m) { const int row = ai * HALF + wr * 64 + m * 16 + fr; const f32x4 v0 = acc[ai][bj][m][0] * g0, v1 = acc[ai][bj][m][1] * g1;
                    u32x4 w; w.x = cvt_pk_bf16(v0[0], v0[1]); w.y = cvt_pk_bf16(v0[2], v0[3]); w.z = cvt_pk_bf16(v1[0], v1[1]); w.w = cvt_pk_bf16(v1[2], v1[3]);
                    *(u32x4*)(p0 + (size_t)row * ld + colt) = w; } }
    }
};
struct EpiFFN1 {
    static constexpr bool PERM = true;
    bf16_t* out; const float* rsc; const float* csc; unsigned* amax; int ld;
    __device__ __forceinline__ void operator()(const f32x4 (&acc)[2][2][4][2], const Unit& u, int wr, int wc, int fr, int fq) const {
        asm volatile("" : "+v"(fr), "+v"(fq));
        bf16_t* p0 = out + (size_t)u.pm * BM * ld + (size_t)u.pn * 256 + wc * 32 + 8 * fq;
        f32x4 cs[2][2];
#pragma unroll
        for (int bj = 0; bj < 2; ++bj) { const float* cp = csc + u.pn * 256 + bj * 128 + wc * 32 + 8 * fq; cs[bj][0] = *(const f32x4*)cp * (1.f / 127.f); cs[bj][1] = *(const f32x4*)(cp + 4) * (1.f / 127.f); }
#pragma unroll
        for (int ai = 0; ai < 2; ++ai)
#pragma unroll
            for (int m = 0; m < 4; ++m) { const int row = ai * HALF + wr * 64 + m * 16 + fr; const float r = rsc[u.pm * BM + row]; float mx = 0.f;
#pragma unroll
                for (int bj = 0; bj < 2; ++bj) { f32x4 v0 = acc[ai][bj][m][0] * cs[bj][0] * r, v1 = acc[ai][bj][m][1] * cs[bj][1] * r;
#pragma unroll
                    for (int j = 0; j < 4; ++j) { const float a = fmaxf(v0[j], 0.f), b = fmaxf(v1[j], 0.f); v0[j] = a * a; v1[j] = b * b; mx = fmaxf(mx, fmaxf(v0[j], v1[j])); }
                    u32x4 w; w.x = cvt_pk_bf16(v0[0], v0[1]); w.y = cvt_pk_bf16(v0[2], v0[3]); w.z = cvt_pk_bf16(v1[0], v1[1]); w.w = cvt_pk_bf16(v1[2], v1[3]);
                    *(u32x4*)(p0 + (size_t)row * ld + bj * 128) = w; }
                (void)mx; }
    }
};

template <bool RF32, bool SSQ>
struct EpiResB {
    static constexpr bool PERM = true;
    const void* R; bf16_t* Hb; float* ssq; int ldc; int rows_per_z; unsigned char* H8; unsigned* rmax; const float* rsc; const float* csc; const int* coff; float ascale;
    __device__ __forceinline__ void operator()(const f32x4 (&acc)[2][2][4][2], const Unit& u, int wr, int wc, int fr, int fq) const {
        asm volatile("" : "+v"(fr), "+v"(fq));
        const size_t row0 = (size_t)u.z * rows_per_z + (size_t)u.pm * BM + wr * 64 + fr; const int colb = u.pn * BM + wc * 32 + 8 * fq;
        f32x4 cs[2][2], of[2][2];
#pragma unroll
        for (int bj = 0; bj < 2; ++bj) { if (coff) { const int* op = coff + colb + bj * HALF;
#pragma unroll
                for (int e = 0; e < 4; ++e) { of[bj][0][e] = 128.f * (float)op[e]; of[bj][1][e] = 128.f * (float)op[4 + e]; } } else { of[bj][0] = (f32x4){0.f, 0.f, 0.f, 0.f}; of[bj][1] = of[bj][0]; }
            if (csc) { cs[bj][0] = *(const f32x4*)(csc + colb + bj * HALF) * (ascale / 127.f); cs[bj][1] = *(const f32x4*)(csc + colb + bj * HALF + 4) * (ascale / 127.f); }
            else { cs[bj][0] = (f32x4){ascale, ascale, ascale, ascale}; cs[bj][1] = cs[bj][0]; } }
#pragma unroll
        for (int ai = 0; ai < 2; ++ai)
#pragma unroll
            for (int m = 0; m < 4; ++m) { const size_t row = row0 + ai * HALF + m * 16; float s = 0.f, mx = 0.f; const float rf = rsc ? rsc[row] : 1.f;
#pragma unroll
                for (int bj = 0; bj < 2; ++bj) { const size_t off = row * ldc + colb + bj * HALF; f32x4 r0, r1;
                    if (RF32) { r0 = __builtin_nontemporal_load((const f32x4*)((const float*)R + off)); r1 = __builtin_nontemporal_load((const f32x4*)((const float*)R + off + 4)); }
                    else { const u32x4 w = *(const u32x4*)((const bf16_t*)R + off); r0 = (f32x4){bflo(w.x), bfhi(w.x), bflo(w.y), bfhi(w.y)}; r1 = (f32x4){bflo(w.z), bfhi(w.z), bflo(w.w), bfhi(w.w)}; }
                    const f32x4 o0 = (acc[ai][bj][m][0] + of[bj][0]) * (cs[bj][0] * rf) + r0, o1 = (acc[ai][bj][m][1] + of[bj][1]) * (cs[bj][1] * rf) + r1;
                    u32x4 w; w.x = cvt_pk_bf16(o0[0], o0[1]); w.y = cvt_pk_bf16(o0[2], o0[3]); w.z = cvt_pk_bf16(o1[0], o1[1]); w.w = cvt_pk_bf16(o1[2], o1[3]);
                    *(u32x4*)(Hb + off) = w;
                    if (H8) *(u32x2*)(H8 + off) = cvt_pk8_fp8(o0, o1);
                    if (rmax) mx = fmaxf(mx, fmaxf(fmaxf(fmaxf(fabsf(o0[0]), fabsf(o0[1])), fmaxf(fabsf(o0[2]), fabsf(o0[3]))), fmaxf(fmaxf(fabsf(o1[0]), fabsf(o1[1])), fmaxf(fabsf(o1[2]), fabsf(o1[3])))));
                    if (SSQ) s += ((o0[0] * o0[0] + o0[1] * o0[1]) + (o0[2] * o0[2] + o0[3] * o0[3])) + ((o1[0] * o1[0] + o1[1] * o1[1]) + (o1[2] * o1[2] + o1[3] * o1[3])); }
                if (SSQ) { s += __shfl_xor(s, 16); s += __shfl_xor(s, 32); if (fq == 0) atomicAdd(ssq + row, s); }
                if (rmax) { mx = fmaxf(mx, __shfl_xor(mx, 16)); mx = fmaxf(mx, __shfl_xor(mx, 32)); if (fq == 0) atomicMax(rmax + row, __float_as_uint(mx)); }
                asm volatile("" ::: "memory"); }
    }
};

struct EpiSoftmax {
    static constexpr bool PERM = true;
    unsigned char* P; const float* rss; int ldp; float scale; int rows_per_z; LAS float* tab;
    __device__ __forceinline__ void operator()(f32x4 (&acc)[2][2][4][2], const Unit& u, int wr, int wc, int fr, int fq) const {
        asm volatile("" : "+v"(fr), "+v"(fq));
        const size_t row0 = (size_t)u.z * rows_per_z + (size_t)u.pm * BM; const int rl0 = wr * 64 + fr;
        LAS float* tmax = tab; LAS float* tsum = tab + 1024;
#pragma unroll
        for (int ai = 0; ai < 2; ++ai)
#pragma unroll
            for (int m = 0; m < 4; ++m) { const int rl = rl0 + ai * HALF + m * 16; const float sc = scale * 1.4426950408889634f * rsqrtf(rss[row0 + rl] * (1.f / DM) + NORM_EPS); float mx = -3.0e38f;
#pragma unroll
                for (int bj = 0; bj < 2; ++bj)
#pragma unroll
                    for (int n = 0; n < 2; ++n) { acc[ai][bj][m][n] = acc[ai][bj][m][n] * sc; const f32x4 v = acc[ai][bj][m][n]; mx = fmaxf(mx, fmaxf(fmaxf(v[0], v[1]), fmaxf(v[2], v[3]))); }
                mx = fmaxf(mx, __shfl_xor(mx, 16)); mx = fmaxf(mx, __shfl_xor(mx, 32));
                if (fq == 0) tmax[rl * 4 + wc] = mx; }
        asm volatile("s_waitcnt lgkmcnt(0)" ::: "memory"); __builtin_amdgcn_s_barrier(); asm volatile("" ::: "memory");
#pragma unroll
        for (int ai = 0; ai < 2; ++ai)
#pragma unroll
            for (int m = 0; m < 4; ++m) { const int rl = rl0 + ai * HALF + m * 16; const f32x4 t = *(LAS const f32x4*)(tmax + rl * 4); const float mx = fmaxf(fmaxf(t[0], t[1]), fmaxf(t[2], t[3])); float sm = 0.f;
#pragma unroll
                for (int bj = 0; bj < 2; ++bj)
#pragma unroll
                    for (int n = 0; n < 2; ++n) { f32x4 v = acc[ai][bj][m][n];
#pragma unroll
                        for (int j = 0; j < 4; ++j) v[j] = __builtin_amdgcn_exp2f(v[j] - mx);
                        acc[ai][bj][m][n] = v; sm += (v[0] + v[1]) + (v[2] + v[3]); }
                sm += __shfl_xor(sm, 16); sm += __shfl_xor(sm, 32);
                if (fq == 0) tsum[rl * 4 + wc] = sm; }
        asm volatile("s_waitcnt lgkmcnt(0)" ::: "memory"); __builtin_amdgcn_s_barrier(); asm volatile("" ::: "memory");
#pragma unroll
        for (int ai = 0; ai < 2; ++ai)
#pragma unroll
            for (int m = 0; m < 4; ++m) { const int rl = rl0 + ai * HALF + m * 16; const f32x4 t = *(LAS const f32x4*)(tsum + rl * 4); const float inv = __builtin_amdgcn_rcpf((t[0] + t[1]) + (t[2] + t[3]));
#pragma unroll
                for (int bj = 0; bj < 2; ++bj) { const f32x4 v0 = acc[ai][bj][m][0] * (inv * 256.f), v1 = acc[ai][bj][m][1] * (inv * 256.f);
                    *(u32x2*)(P + (row0 + rl) * ldp + u.pn * BM + bj * HALF + wc * 32 + 8 * fq) = cvt_pk8_fp8(v0, v1); } }
    }
};

struct EpiF8ColGain {
    static constexpr bool PERM = true;
    unsigned char* out; const float* cg; int ld, nZ2; size_t sz1, sz2, spm, spn;
    __device__ __forceinline__ void operator()(const f32x4 (&acc)[2][2][4][2], const Unit& u, int wr, int wc, int fr, int fq) const {
        asm volatile("" : "+v"(fr), "+v"(fq));
        unsigned char* p0 = out + (size_t)(u.z / nZ2) * sz1 + (size_t)(u.z % nZ2) * sz2 + (size_t)u.pm * spm + (size_t)u.pn * spn;
#pragma unroll
        for (int bj = 0; bj < 2; ++bj) { const int colt = bj * 128 + wc * 32 + 8 * fq; const f32x4 g0 = *(const f32x4*)(cg + u.pn * 256 + colt), g1 = *(const f32x4*)(cg + u.pn * 256 + colt + 4);
#pragma unroll
            for (int ai = 0; ai < 2; ++ai)
#pragma unroll
                for (int m = 0; m < 4; ++m) { const int row = ai * HALF + wr * 64 + m * 16 + fr;
                    *(u32x2*)(p0 + (size_t)row * ld + colt) = cvt_pk8_fp8(acc[ai][bj][m][0] * g0, acc[ai][bj][m][1] * g1); } }
    }
};
struct EpiF8Lin {
    static constexpr bool PERM = true;
    unsigned char* out; int ld, nZ2; size_t sz1, sz2, spm, spn;
    __device__ __forceinline__ void operator()(const f32x4 (&acc)[2][2][4][2], const Unit& u, int wr, int wc, int fr, int fq) const {
        asm volatile("" : "+v"(fr), "+v"(fq));
        unsigned char* p0 = out + (size_t)(u.z / nZ2) * sz1 + (size_t)(u.z % nZ2) * sz2 + (size_t)u.pm * spm + (size_t)u.pn * spn;
#pragma unroll
        for (int bj = 0; bj < 2; ++bj) { const int colt = bj * 128 + wc * 32 + 8 * fq;
#pragma unroll
            for (int ai = 0; ai < 2; ++ai)
#pragma unroll
                for (int m = 0; m < 4; ++m) { const int row = ai * HALF + wr * 64 + m * 16 + fr;
                    *(u32x2*)(p0 + (size_t)row * ld + colt) = cvt_pk8_fp8(acc[ai][bj][m][0], acc[ai][bj][m][1]); } }
    }
};
}

namespace att {
constexpr int QBLK = 32, KVBLK = 64;
constexpr int LDQ = NH * DQK, LDK = NH * DQK, LDV = NH * DV, LDO = FW;
constexpr int KROW = 400;
constexpr int SHM_V = KVBLK * DV * 2, SHM_K = KVBLK * KROW, SHM_ATTN = 2 * SHM_V + 2 * SHM_K + NWAVES * 64 * 4;
static_assert(SHM_ATTN <= RING_BYTES, "attention LDS");
constexpr float THR = 11.54f;
#define SBAR() __builtin_amdgcn_sched_barrier(0)
__device__ __forceinline__ int crow(int r, int hi) { return (r & 3) + 8 * (r >> 2) + 4 * hi; }
__device__ __forceinline__ void partialSM(f32x16& p0, f32x16& p1, float& m_reg, float& mn, float& alpha) {
  float pmax = p0[0];
#pragma unroll
  for (int r = 1; r < 16; ++r) pmax = fmaxf(pmax, p0[r]);
#pragma unroll
  for (int r = 0; r < 16; ++r) pmax = fmaxf(pmax, p1[r]);
  { auto rr = __builtin_amdgcn_permlane32_swap(__float_as_uint(pmax), __float_as_uint(pmax), false, false);
    pmax = fmaxf(__uint_as_float(rr[0]), __uint_as_float(rr[1])); }
  if (__builtin_expect(__all(pmax - m_reg <= THR), 1)) { mn = m_reg; alpha = 1.f; }
  else { mn = fmaxf(m_reg, pmax); alpha = __builtin_amdgcn_exp2f(m_reg - mn); m_reg = mn; }
#pragma unroll
  for (int r = 0; r < 16; ++r) p0[r] = p0[r] - mn;
#pragma unroll
  for (int r = 0; r < 16; ++r) p1[r] = p1[r] - mn;
#pragma unroll
  for (int r = 0; r < 16; ++r) p0[r] = __builtin_amdgcn_exp2f(p0[r]);
}
__device__ __forceinline__ void finishSM(f32x16& p0, f32x16& p1, float alpha, float& l_reg, bf16x8& pa0, bf16x8& pa1, bf16x8& pa2, bf16x8& pa3) {
#pragma unroll
  for (int r = 0; r < 16; ++r) p1[r] = __builtin_amdgcn_exp2f(p1[r]);
  float ps = 0;
#pragma unroll
  for (int r = 0; r < 16; ++r) ps += p0[r];
#pragma unroll
  for (int r = 0; r < 16; ++r) ps += p1[r];
  { auto rr = __builtin_amdgcn_permlane32_swap(__float_as_uint(ps), __float_as_uint(ps), false, false);
    ps = __uint_as_float(rr[0]) + __uint_as_float(rr[1]); }
  l_reg = l_reg * alpha + ps;
#define PK4(P, BASE, OUT) do { unsigned a0 = cvt_pk_bf16(P[BASE + 0], P[BASE + 1]), a1 = cvt_pk_bf16(P[BASE + 2], P[BASE + 3]);   \
    unsigned b0 = cvt_pk_bf16(P[BASE + 4], P[BASE + 5]), b1 = cvt_pk_bf16(P[BASE + 6], P[BASE + 7]);                              \
    auto r0 = __builtin_amdgcn_permlane32_swap(a0, b0, false, false); auto r1 = __builtin_amdgcn_permlane32_swap(a1, b1, false, false); \
    u32x4 w = {r0[0], r1[0], r0[1], r1[1]}; OUT = *reinterpret_cast<bf16x8*>(&w); } while (0)
  PK4(p0, 0, pa0); PK4(p0, 8, pa1); PK4(p1, 0, pa2); PK4(p1, 8, pa3);
#undef PK4
}
__device__ __forceinline__ void qkt(f32x16& p0, f32x16& p1, const char* Ks, const bf16x8 (&qr)[12], int r32, int hi) {
  p0 = f32x16{}; p1 = f32x16{};
#pragma unroll
  for (int d0 = 0; d0 < 12; ++d0) { const int cb = (d0 * 16 + hi * 8) * 2;
    bf16x8 b0 = *reinterpret_cast<const bf16x8*>(Ks + r32 * KROW + cb);
    bf16x8 b1 = *reinterpret_cast<const bf16x8*>(Ks + (32 + r32) * KROW + cb);
    p0 = __builtin_amdgcn_mfma_f32_32x32x16_bf16(b0, qr[d0], p0, 0, 0, 0);
    p1 = __builtin_amdgcn_mfma_f32_32x32x16_bf16(b1, qr[d0], p1, 0, 0, 0); }
}
__device__ __forceinline__ int v_st(int k, int c) { const int kk = (k & ~0xC) | ((k & 4) << 1) | ((k & 8) >> 1); return ((kk >> 3) * 4 + (c >> 5)) * 512 + ((kk & 7) * 32 + (c & 31)) * 2; }
__device__ __forceinline__ int v_rd_base(int lane) { return ((lane & 3) << 3) | (((lane >> 2) & 3) << 6) | (((lane >> 4) & 1) << 5) | (((lane >> 5) & 1) << 8); }
constexpr int v_rd_off(int d0, int ks, int half) { return d0 * 512 + ks * 4096 + half * 2048; }
template <int OFF> __device__ __forceinline__ s16x4 tr_read(int vb) {
  s16x4 r; asm volatile("ds_read_b64_tr_b16 %0, %1 offset:%2" : "=&v"(r) : "v"(vb), "i"(OFF) : "memory"); return r;
}
template <int D0> __device__ __forceinline__ void pv_one(f32x16& od, int vb, bf16x8 pa0, bf16x8 pa1, bf16x8 pa2, bf16x8 pa3) {
  const s16x4 l0 = tr_read<v_rd_off(D0, 0, 0)>(vb), h0 = tr_read<v_rd_off(D0, 0, 1)>(vb), l1 = tr_read<v_rd_off(D0, 1, 0)>(vb), h1 = tr_read<v_rd_off(D0, 1, 1)>(vb);
  const s16x4 l2 = tr_read<v_rd_off(D0, 2, 0)>(vb), h2 = tr_read<v_rd_off(D0, 2, 1)>(vb), l3 = tr_read<v_rd_off(D0, 3, 0)>(vb), h3 = tr_read<v_rd_off(D0, 3, 1)>(vb);
  asm volatile("s_waitcnt lgkmcnt(0)" ::: "memory"); SBAR();
#define PK(L, H) (bf16x8){L[0], L[1], L[2], L[3], H[0], H[1], H[2], H[3]}
  od = __builtin_amdgcn_mfma_f32_32x32x16_bf16(pa0, PK(l0, h0), od, 0, 0, 0);
  od = __builtin_amdgcn_mfma_f32_32x32x16_bf16(pa1, PK(l1, h1), od, 0, 0, 0);
  od = __builtin_amdgcn_mfma_f32_32x32x16_bf16(pa2, PK(l2, h2), od, 0, 0, 0);
  od = __builtin_amdgcn_mfma_f32_32x32x16_bf16(pa3, PK(l3, h3), od, 0, 0, 0);
#undef PK
}
__device__ __forceinline__ void pv_d0(f32x16* o, int vb, bf16x8 pa0, bf16x8 pa1, bf16x8 pa2, bf16x8 pa3) {
  pv_one<0>(o[0], vb, pa0, pa1, pa2, pa3); pv_one<1>(o[1], vb, pa0, pa1, pa2, pa3); pv_one<2>(o[2], vb, pa0, pa1, pa2, pa3); pv_one<3>(o[3], vb, pa0, pa1, pa2, pa3);
}
template <int D0> __device__ __forceinline__ void pv_rd(s16x4 (&f)[8], int vb) {
  f[0] = tr_read<v_rd_off(D0, 0, 0)>(vb); f[1] = tr_read<v_rd_off(D0, 0, 1)>(vb); f[2] = tr_read<v_rd_off(D0, 1, 0)>(vb); f[3] = tr_read<v_rd_off(D0, 1, 1)>(vb);
  f[4] = tr_read<v_rd_off(D0, 2, 0)>(vb); f[5] = tr_read<v_rd_off(D0, 2, 1)>(vb); f[6] = tr_read<v_rd_off(D0, 3, 0)>(vb); f[7] = tr_read<v_rd_off(D0, 3, 1)>(vb);
}
__device__ __forceinline__ void pv_mm(f32x16& od, const s16x4 (&f)[8], bf16x8 pa0, bf16x8 pa1, bf16x8 pa2, bf16x8 pa3) {
#define PK(L, H) (bf16x8){L[0], L[1], L[2], L[3], H[0], H[1], H[2], H[3]}
  od = __builtin_amdgcn_mfma_f32_32x32x16_bf16(pa0, PK(f[0], f[1]), od, 0, 0, 0);
  od = __builtin_amdgcn_mfma_f32_32x32x16_bf16(pa1, PK(f[2], f[3]), od, 0, 0, 0);
  od = __builtin_amdgcn_mfma_f32_32x32x16_bf16(pa2, PK(f[4], f[5]), od, 0, 0, 0);
  od = __builtin_amdgcn_mfma_f32_32x32x16_bf16(pa3, PK(f[6], f[7]), od, 0, 0, 0);
#undef PK
}
__device__ __forceinline__ void pv_d0p(f32x16* o, int vb, bf16x8 pa0, bf16x8 pa1, bf16x8 pa2, bf16x8 pa3) {
  s16x4 fa[8], fb[8];
  pv_rd<0>(fa, vb); pv_rd<1>(fb, vb);
  asm volatile("s_waitcnt lgkmcnt(8)" ::: "memory"); SBAR(); pv_mm(o[0], fa, pa0, pa1, pa2, pa3); SBAR();
  pv_rd<2>(fa, vb);
  asm volatile("s_waitcnt lgkmcnt(8)" ::: "memory"); SBAR(); pv_mm(o[1], fb, pa0, pa1, pa2, pa3); SBAR();
  pv_rd<3>(fb, vb);
  asm volatile("s_waitcnt lgkmcnt(8)" ::: "memory"); SBAR(); pv_mm(o[2], fa, pa0, pa1, pa2, pa3); SBAR();
  asm volatile("s_waitcnt lgkmcnt(0)" ::: "memory"); SBAR(); pv_mm(o[3], fb, pa0, pa1, pa2, pa3);
}
}


namespace att2 {
using namespace att;
constexpr int KSLOT = KVBLK * DQK * 2, VSLOT = KVBLK * DV * 2, K_OFF = 0, V_OFF = 3 * KSLOT, WS_OFF = V_OFF + 3 * VSLOT, SHM2 = WS_OFF + NWAVES * 64 * 4;
static_assert(SHM2 <= RING_BYTES, "attention v2 LDS");
__device__ __forceinline__ void qkt2(f32x16& p0, f32x16& p1, LAS const unsigned char* ks, const int (&kx)[4], const bf16x8 (&qr)[12]) {
  p0 = f32x16{}; p1 = f32x16{};
#pragma unroll
  for (int d0 = 0; d0 < 12; ++d0) {
    const bf16x8 b0 = *(LAS const bf16x8*)(ks + kx[d0 & 3] + (d0 >> 2) * 1024);
    const bf16x8 b1 = *(LAS const bf16x8*)(ks + kx[d0 & 3] + (d0 >> 2) * 1024 + 12288);
    p0 = __builtin_amdgcn_mfma_f32_32x32x16_bf16(b0, qr[d0], p0, 0, 0, 0);
    p1 = __builtin_amdgcn_mfma_f32_32x32x16_bf16(b1, qr[d0], p1, 0, 0, 0); }
}
}


namespace att4 {
using namespace att;
using namespace att2;
template <int ORDER>
__device__ __forceinline__ void attn_unit4(const bf16_t* __restrict__ Qb, const bf16_t* __restrict__ Kh, const bf16_t* __restrict__ Vh, bf16_t* __restrict__ Ob, int seq, LAS unsigned char* lds) {
  const int tid = threadIdx.x, wid = __builtin_amdgcn_readfirstlane(tid >> 6), lane = tid & 63, r32 = lane & 31, hi = lane >> 5;
  LAS float* ws = (LAS float*)(lds + WS_OFF) + wid * 64; LAS float* li_l = ws; LAS float* al_l = ws + 32;
  float m_reg = -1e30f, l_reg = 0; f32x16 o[4] = {}; bf16x8 qr[12];
  const bf16_t* Qw = Qb + (long)(wid * QBLK + r32) * LDQ + hi * 8;
#pragma unroll
  for (int d0 = 0; d0 < 12; ++d0) qr[d0] = *reinterpret_cast<const bf16x8*>(Qw + d0 * 16);
  unsigned voffK[3], voffV[2];
  { const int row = wid * 8 + (lane >> 3), f = (row >> 1) & 7, j = lane & 7;
#pragma unroll
    for (int i = 0; i < 3; ++i) voffK[i] = (unsigned)((row * LDK + (i * 8 + (j ^ f)) * 8) * 2);
#pragma unroll
    for (int i = 0; i < 2; ++i) { const int B = wid * 2 + i, st = 2 * B + (lane >> 5), kk = (st >> 2) * 8 + ((lane & 31) >> 2), c = (st & 3) * 32 + (lane & 3) * 8;
      const int k = (kk & ~0xC) | ((kk & 4) << 1) | ((kk & 8) >> 1); voffV[i] = (unsigned)((k * LDV + c) * 2); } }
  int kx[4];
  { const int f = (r32 >> 1) & 7, base0 = (r32 >> 3) * 3072 + (r32 & 7) * 128;
#pragma unroll
    for (int m = 0; m < 4; ++m) kx[m] = base0 + (((2 * m + hi) ^ f) << 4); }
  const int vb0 = (int)(uintptr_t)(lds + V_OFF) + v_rd_base(lane);
  const int NT = seq / KVBLK;
#define DMA_GROUP(t) do { const int tk_ = ((t) + 2 < NT) ? (t) + 2 : NT - 1, tv_ = ((t) + 1 < NT) ? (((t) + 1 < 0) ? 0 : (t) + 1) : NT - 1; const int sk_ = ((t) + 2) % 3, sv_ = ((t) + 4) % 3; \
    const char* kg_ = (const char*)Kh + (size_t)tk_ * (KVBLK * LDK * 2); const char* vg_ = (const char*)Vh + (size_t)tv_ * (KVBLK * LDV * 2); \
    _Pragma("unroll") for (int i_ = 0; i_ < 3; ++i_) __builtin_amdgcn_global_load_lds((const unsigned*)(kg_ + voffK[i_]), (LAS unsigned*)(lds + K_OFF + sk_ * KSLOT + (wid * 3 + i_) * 1024), 16, 0, 0); \
    _Pragma("unroll") for (int i_ = 0; i_ < 2; ++i_) __builtin_amdgcn_global_load_lds((const unsigned*)(vg_ + voffV[i_]), (LAS unsigned*)(lds + V_OFF + sv_ * VSLOT + (wid * 2 + i_) * 1024), 16, 0, 0); } while (0)
#define TILE_SYNC() do { asm volatile("s_waitcnt vmcnt(5)" ::: "memory"); __builtin_amdgcn_s_barrier(); asm volatile("" ::: "memory"); } while (0)
#define RESC(a) do { if (__any((a) < 1.f)) { if (hi == 0) al_l[r32] = (a); asm volatile("s_waitcnt lgkmcnt(0)" ::: "memory"); \
    _Pragma("unroll") for (int d = 0; d < 4; ++d) _Pragma("unroll") for (int r = 0; r < 16; ++r) o[d][r] *= al_l[crow(r, hi)]; } } while (0)
  f32x16 pA0, pA1, pB0, pB1; float mnA, mnB, alA, alB; bf16x8 pa0, pa1, pa2, pa3;
  asm volatile("s_waitcnt vmcnt(0)" ::: "memory");
  DMA_GROUP(-2); DMA_GROUP(-1);
  TILE_SYNC(); DMA_GROUP(0);
  qkt2(pA0, pA1, lds + K_OFF, kx, qr); partialSM(pA0, pA1, m_reg, mnA, alA);
  int ks = 1, vs = 0;
#define TILE_BODY0(PN0, PN1, MNN, ALN, PF0, PF1, ALF) do { \
    SBAR(); qkt2(PN0, PN1, lds + K_OFF + ks * KSLOT, kx, qr); finishSM(PF0, PF1, ALF, l_reg, pa0, pa1, pa2, pa3); SBAR(); \
    pv_d0(o, vb0 + vs * VSLOT, pa0, pa1, pa2, pa3); partialSM(PN0, PN1, m_reg, MNN, ALN); \
    RESC(ALN); ks = (ks == 2) ? 0 : ks + 1; vs = (vs == 2) ? 0 : vs + 1; } while (0)
#define TILE_BODY1(PN0, PN1, MNN, ALN, PF0, PF1, ALF) do { \
    SBAR(); finishSM(PF0, PF1, ALF, l_reg, pa0, pa1, pa2, pa3); SBAR(); qkt2(PN0, PN1, lds + K_OFF + ks * KSLOT, kx, qr); SBAR(); \
    partialSM(PN0, PN1, m_reg, MNN, ALN); SBAR(); pv_d0(o, vb0 + vs * VSLOT, pa0, pa1, pa2, pa3); SBAR(); \
    RESC(ALN); ks = (ks == 2) ? 0 : ks + 1; vs = (vs == 2) ? 0 : vs + 1; } while (0)
#define TILE_BODY(...) do { if constexpr (ORDER == 0) TILE_BODY0(__VA_ARGS__); else TILE_BODY1(__VA_ARGS__); } while (0)
  for (int j = 1; j + 1 < NT; j += 2) {
    TILE_SYNC(); DMA_GROUP(j);
    TILE_BODY(pB0, pB1, mnB, alB, pA0, pA1, alA);
    TILE_SYNC(); DMA_GROUP(j + 1);
    TILE_BODY(pA0, pA1, mnA, alA, pB0, pB1, alB);
  }
  TILE_SYNC(); DMA_GROUP(NT - 1);
  TILE_BODY(pB0, pB1, mnB, alB, pA0, pA1, alA);
#undef TILE_BODY
  finishSM(pB0, pB1, alB, l_reg, pa0, pa1, pa2, pa3); SBAR();
  TILE_SYNC();
  pv_d0(o, vb0 + vs * VSLOT, pa0, pa1, pa2, pa3);
#undef TILE_BODY0
#undef TILE_BODY1
  if (hi == 0) li_l[r32] = l_reg; asm volatile("s_waitcnt lgkmcnt(0)" ::: "memory");
  float rli[16];
#pragma unroll
  for (int r = 0; r < 16; ++r) rli[r] = __builtin_amdgcn_rcpf(li_l[crow(r, hi)]);
  bf16_t* Ow = Ob + (long)(wid * QBLK) * LDO;
#pragma unroll
  for (int r = 0; r < 16; ++r) { const int orow = crow(r, hi);
#pragma unroll
    for (int d0 = 0; d0 < 4; ++d0) Ow[(long)orow * LDO + d0 * 32 + r32] = (bf16_t)(cvt_pk_bf16(o[d0][r] * rli[r], 0.f) & 0xffffu); }
  asm volatile("s_waitcnt vmcnt(0) lgkmcnt(0)" ::: "memory"); __builtin_amdgcn_s_barrier(); asm volatile("" ::: "memory");
#undef DMA_GROUP
#undef TILE_SYNC
#undef RESC
}
__device__ __forceinline__ void attn_body4(const bf16_t* __restrict__ Qb, const bf16_t* __restrict__ Kh, const bf16_t* __restrict__ Vh, bf16_t* __restrict__ Ob, int seq, LAS unsigned char* lds) {
  if (__builtin_amdgcn_readfirstlane(threadIdx.x >> 6) < 4) attn_unit4<0>(Qb, Kh, Vh, Ob, seq, lds); else attn_unit4<1>(Qb, Kh, Vh, Ob, seq, lds);
}
}

namespace att8 {
using namespace att;
using namespace att2;
typedef int v4i __attribute__((ext_vector_type(4)));
typedef int v16i __attribute__((ext_vector_type(16)));
constexpr int K8SLOT = KVBLK * DQK, SSLOT = 1024, K8_OFF = 0, V8_OFF = 3 * K8SLOT, S8_OFF = V8_OFF + 3 * VSLOT, WS8_OFF = S8_OFF + 3 * SSLOT, SHM8 = WS8_OFF + NWAVES * 64 * 4;
static_assert(SHM8 <= RING_BYTES, "attention v8 LDS");
constexpr float MAGICF = 12582912.f; constexpr int MAGICI = 0x4B400000;
__device__ __forceinline__ void qkt8(f32x16& p0, f32x16& p1, float& t0, float& t1, LAS const unsigned char* kl  , LAS const unsigned char* sl  , const v4i (&qr)[6], const v16i& mg, float sq) {
  v16i a0, a1;
#pragma unroll
  for (int cp = 0; cp < 6; ++cp) {
    const v4i b0 = *(LAS const v4i*)(kl + (2 * cp) * 1024), b1 = *(LAS const v4i*)(kl + (2 * cp + 1) * 1024);
    a0 = __builtin_amdgcn_mfma_i32_32x32x32_i8(b0, qr[cp], cp ? a0 : mg, 0, 0, 0);
    a1 = __builtin_amdgcn_mfma_i32_32x32x32_i8(b1, qr[cp], cp ? a1 : mg, 0, 0, 0); }
  const f32x2 st = *(LAS const f32x2*)sl; t0 = st[0] * sq; t1 = st[1] * sq;
  p0 = __builtin_bit_cast(f32x16, a0); p1 = __builtin_bit_cast(f32x16, a1);
}
template <bool ZM>
__device__ __forceinline__ void partialSM8(f32x16& p0, f32x16& p1, float& m_reg, float& mn, float& alpha, float t0, float t1) {
  if constexpr (ZM) {
    const float u0 = MAGICF * t0, u1 = MAGICF * t1; mn = 0.f; alpha = 1.f;
#pragma unroll
    for (int r = 0; r < 16; ++r) p0[r] = __builtin_fmaf(p0[r], t0, -u0);
#pragma unroll
    for (int r = 0; r < 16; ++r) p1[r] = __builtin_fmaf(p1[r], t1, -u1);
#pragma unroll
    for (int r = 0; r < 16; ++r) p0[r] = __builtin_amdgcn_exp2f(p0[r]);
    return; }
  float f0 = p0[0], f1 = p1[0];
#pragma unroll
  for (int r = 1; r < 16; ++r) { f0 = fmaxf(f0, p0[r]); f1 = fmaxf(f1, p1[r]); }
  float pmax = fmaxf(__builtin_fmaf(f0, t0, -MAGICF * t0), __builtin_fmaf(f1, t1, -MAGICF * t1));
  { auto rr = __builtin_amdgcn_permlane32_swap(__float_as_uint(pmax), __float_as_uint(pmax), false, false);
    pmax = fmaxf(__uint_as_float(rr[0]), __uint_as_float(rr[1])); }
  if (__builtin_expect(__all(pmax - m_reg <= THR), 1)) { mn = m_reg; alpha = 1.f; }
  else { mn = fmaxf(m_reg, pmax); alpha = __builtin_amdgcn_exp2f(m_reg - mn); m_reg = mn; }
  const float u0 = __builtin_fmaf(MAGICF, t0, mn), u1 = __builtin_fmaf(MAGICF, t1, mn);
#pragma unroll
  for (int r = 0; r < 16; ++r) p0[r] = __builtin_fmaf(p0[r], t0, -u0);
#pragma unroll
  for (int r = 0; r < 16; ++r) p1[r] = __builtin_fmaf(p1[r], t1, -u1);
#pragma unroll
  for (int r = 0; r < 16; ++r) p0[r] = __builtin_amdgcn_exp2f(p0[r]);
}
template <int ORDER, bool ZM>
__device__ __forceinline__ bool attn_unit8(const bf16_t* __restrict__ Qbw  ,
                                            const signed char* __restrict__ K8h, const float* __restrict__ ksh, const bf16_t* __restrict__ Vh, bf16_t* __restrict__ Ob, int seq, LAS unsigned char* lds) {
  const int tid = threadIdx.x, wid = __builtin_amdgcn_readfirstlane(tid >> 6), lane = tid & 63, r32 = lane & 31, hi = lane >> 5;
  LAS float* ws = (LAS float*)(lds + WS8_OFF) + wid * 64; LAS float* li_l = ws; LAS float* al_l = ws + 32;
  float m_reg = -1e30f, l_reg = 0; f32x16 o[4] = {}; v4i qr[6];
  float sq;
  { const bf16_t* Qw = Qbw + (long)(wid * QBLK + r32) * LDQ + hi * 16; u32x4 raw[12]; float mx = 0.f;
#pragma unroll
    for (int cp = 0; cp < 6; ++cp) { raw[2 * cp] = *reinterpret_cast<const u32x4*>(Qw + cp * 32); raw[2 * cp + 1] = *reinterpret_cast<const u32x4*>(Qw + cp * 32 + 8); }
#pragma unroll
    for (int j = 0; j < 12; ++j)
#pragma unroll
      for (int e = 0; e < 4; ++e) mx = fmaxf(mx, fmaxf(fabsf(bflo(raw[j][e])), fabsf(bfhi(raw[j][e]))));
    { auto rr = __builtin_amdgcn_permlane32_swap(__float_as_uint(mx), __float_as_uint(mx), false, false); mx = fmaxf(__uint_as_float(rr[0]), __uint_as_float(rr[1])); }
    const float isc = mx > 0.f ? 127.f / mx : 0.f; sq = mx * (1.f / 127.f);
#pragma unroll
    for (int cp = 0; cp < 6; ++cp)
#pragma unroll
      for (int w = 0; w < 4; ++w) { const u32x4& a = raw[2 * cp + (w >> 1)]; const unsigned x0 = a[(w & 1) * 2], x1 = a[(w & 1) * 2 + 1];
        const int q0 = (int)__builtin_rintf(bflo(x0) * isc) & 0xff, q1 = (int)__builtin_rintf(bfhi(x0) * isc) & 0xff, q2 = (int)__builtin_rintf(bflo(x1) * isc) & 0xff, q3 = (int)__builtin_rintf(bfhi(x1) * isc) & 0xff;
        qr[cp][w] = q0 | (q1 << 8) | (q2 << 16) | (q3 << 24); } }
  constexpr int NKP = (ORDER == 0) ? 2 : 1;
  unsigned voffK[NKP], voffV[2]; int kpiece0;
  { kpiece0 = (ORDER == 0) ? 2 * wid : 8 + (wid - 4);
#pragma unroll
    for (int i = 0; i < NKP; ++i) { const int p = kpiece0 + i, cp = p >> 1, hf = p & 1; voffK[i] = (unsigned)((32 * hf + r32) * DQK + (2 * cp + hi) * 16); }
#pragma unroll
    for (int i = 0; i < 2; ++i) { const int B = wid * 2 + i, st = 2 * B + (lane >> 5), kk = (st >> 2) * 8 + ((lane & 31) >> 2), c = (st & 3) * 32 + (lane & 3) * 8;
      const int k = (kk & ~0xC) | ((kk & 4) << 1) | ((kk & 8) >> 1); voffV[i] = (unsigned)((k * LDV + c) * 2); } }
  LAS const unsigned char* kl0 = lds + K8_OFF + lane * 16; LAS const unsigned char* sl0 = lds + S8_OFF;
  v16i mg; { int m1 = MAGICI; asm volatile("" : "+v"(m1));
#pragma unroll
    for (int r = 0; r < 16; ++r) mg[r] = m1; asm volatile("" : "+v"(mg)); }
  const int vb0 = (int)(uintptr_t)(lds + V8_OFF) + v_rd_base(lane);
  const int NT = seq / KVBLK;
#define DMA_GROUP(t) do { const int tk_ = ((t) + 2 < NT) ? (t) + 2 : NT - 1, tv_ = ((t) + 1 < NT) ? (((t) + 1 < 0) ? 0 : (t) + 1) : NT - 1; const int sk_ = ((t) + 2) % 3, sv_ = ((t) + 4) % 3; \
    const char* kg_ = (const char*)K8h + (size_t)tk_ * (KVBLK * DQK); const char* vg_ = (const char*)Vh + (size_t)tv_ * (KVBLK * LDV * 2); \
    _Pragma("unroll") for (int i_ = 0; i_ < NKP; ++i_) __builtin_amdgcn_global_load_lds((const unsigned*)(kg_ + voffK[i_]), (LAS unsigned*)(lds + K8_OFF + sk_ * K8SLOT + (kpiece0 + i_) * 1024), 16, 0, 0); \
    if constexpr (ORDER == 1) __builtin_amdgcn_global_load_lds((const unsigned*)(ksh + (size_t)tk_ * 2 + (lane & 1)), (LAS unsigned*)(lds + S8_OFF + sk_ * SSLOT + (wid - 4) * 256), 4, 0, 0); \
    _Pragma("unroll") for (int i_ = 0; i_ < 2; ++i_) __builtin_amdgcn_global_load_lds((const unsigned*)(vg_ + voffV[i_]), (LAS unsigned*)(lds + V8_OFF + sv_ * VSLOT + (wid * 2 + i_) * 1024), 16, 0, 0); } while (0)
#define TILE_SYNC() do { asm volatile("s_waitcnt vmcnt(4)" ::: "memory"); __builtin_amdgcn_s_barrier(); asm volatile("" ::: "memory"); } while (0)
#define RESC(a) do { if (!ZM && __any((a) < 1.f)) { if (hi == 0) al_l[r32] = (a); asm volatile("s_waitcnt lgkmcnt(0)" ::: "memory"); \
    _Pragma("unroll") for (int d = 0; d < 4; ++d) _Pragma("unroll") for (int r = 0; r < 16; ++r) o[d][r] *= al_l[crow(r, hi)]; } } while (0)
  f32x16 pA0, pA1, pB0, pB1; float mnA, mnB, alA, alB, tA0, tA1, tB0, tB1; bf16x8 pa0, pa1, pa2, pa3;
  asm volatile("s_waitcnt vmcnt(0)" ::: "memory");
  DMA_GROUP(-2); DMA_GROUP(-1);
  TILE_SYNC(); DMA_GROUP(0);
  qkt8(pA0, pA1, tA0, tA1, kl0, sl0, qr, mg, sq); partialSM8<ZM>(pA0, pA1, m_reg, mnA, alA, tA0, tA1);
  int ks = 1, vs = 0;
#define TILE_BODY0(PN0, PN1, MNN, ALN, TN0, TN1, PF0, PF1, ALF) do { \
    SBAR(); qkt8(PN0, PN1, TN0, TN1, kl0 + ks * K8SLOT, sl0 + ks * SSLOT, qr, mg, sq); finishSM(PF0, PF1, ALF, l_reg, pa0, pa1, pa2, pa3); SBAR(); \
    pv_d0p(o, vb0 + vs * VSLOT, pa0, pa1, pa2, pa3); partialSM8<ZM>(PN0, PN1, m_reg, MNN, ALN, TN0, TN1); \
    RESC(ALN); ks = (ks == 2) ? 0 : ks + 1; vs = (vs == 2) ? 0 : vs + 1; } while (0)
#define TILE_BODY1(PN0, PN1, MNN, ALN, TN0, TN1, PF0, PF1, ALF) do { \
    SBAR(); finishSM(PF0, PF1, ALF, l_reg, pa0, pa1, pa2, pa3); SBAR(); qkt8(PN0, PN1, TN0, TN1, kl0 + ks * K8SLOT, sl0 + ks * SSLOT, qr, mg, sq); SBAR(); \
    partialSM8<ZM>(PN0, PN1, m_reg, MNN, ALN, TN0, TN1); SBAR(); pv_d0p(o, vb0 + vs * VSLOT, pa0, pa1, pa2, pa3); SBAR(); \
    RESC(ALN); ks = (ks == 2) ? 0 : ks + 1; vs = (vs == 2) ? 0 : vs + 1; } while (0)
#define TILE_BODY(...) do { if constexpr (ORDER == 0) TILE_BODY0(__VA_ARGS__); else TILE_BODY1(__VA_ARGS__); } while (0)
  for (int j = 1; j + 1 < NT; j += 2) {
    TILE_SYNC(); DMA_GROUP(j);
    TILE_BODY(pB0, pB1, mnB, alB, tB0, tB1, pA0, pA1, alA);
    TILE_SYNC(); DMA_GROUP(j + 1);
    TILE_BODY(pA0, pA1, mnA, alA, tA0, tA1, pB0, pB1, alB);
  }
  TILE_SYNC(); DMA_GROUP(NT - 1);
  TILE_BODY(pB0, pB1, mnB, alB, tB0, tB1, pA0, pA1, alA);
#undef TILE_BODY
  finishSM(pB0, pB1, alB, l_reg, pa0, pa1, pa2, pa3); SBAR();
  TILE_SYNC();
  pv_d0p(o, vb0 + vs * VSLOT, pa0, pa1, pa2, pa3);
#undef TILE_BODY0
#undef TILE_BODY1
  if (hi == 0) li_l[r32] = l_reg; asm volatile("s_waitcnt lgkmcnt(0)" ::: "memory");
  float rli[16];
#pragma unroll
  for (int r = 0; r < 16; ++r) rli[r] = __builtin_amdgcn_rcpf(li_l[crow(r, hi)]);
  bf16_t* Ow = Ob + (long)(wid * QBLK) * LDO;
#pragma unroll
  for (int r = 0; r < 16; ++r) { const int orow = crow(r, hi);
#pragma unroll
    for (int d0 = 0; d0 < 4; ++d0) Ow[(long)orow * LDO + d0 * 32 + r32] = (bf16_t)(cvt_pk_bf16(o[d0][r] * rli[r], 0.f) & 0xffffu); }
  bool redo = false;
  if constexpr (ZM) { const bool bad = !(l_reg > 1e-20f && l_reg < 1e20f);
    const int ab = __any(bad); if (lane == 0) ws[0] = ab ? 1.f : 0.f; }
  asm volatile("s_waitcnt vmcnt(0) lgkmcnt(0)" ::: "memory"); __builtin_amdgcn_s_barrier(); asm volatile("" ::: "memory");
  if constexpr (ZM) { float f = 0.f;
#pragma unroll
    for (int w = 0; w < NWAVES; ++w) f += ((LAS float*)(lds + WS8_OFF))[w * 64];
    redo = __builtin_amdgcn_readfirstlane(f > 0.f ? 1 : 0) != 0;
    __builtin_amdgcn_s_barrier(); }
#undef DMA_GROUP
#undef TILE_SYNC
#undef RESC
  return redo;
}
__device__ __forceinline__ void attn_body8(const bf16_t* __restrict__ Qbw, const signed char* __restrict__ K8h, const float* __restrict__ ksh, const bf16_t* __restrict__ Vh,
                                           bf16_t* __restrict__ Ob, int seq, LAS unsigned char* lds) {
  bool redo;
  if (__builtin_amdgcn_readfirstlane(threadIdx.x >> 6) < 4) redo = attn_unit8<0, true>(Qbw, K8h, ksh, Vh, Ob, seq, lds); else redo = attn_unit8<1, true>(Qbw, K8h, ksh, Vh, Ob, seq, lds);
  if (__builtin_expect(redo, 0)) {
    if (__builtin_amdgcn_readfirstlane(threadIdx.x >> 6) < 4) attn_unit8<0, false>(Qbw, K8h, ksh, Vh, Ob, seq, lds); else attn_unit8<1, false>(Qbw, K8h, ksh, Vh, Ob, seq, lds); }
}
}

struct Ctx {
    LAS unsigned char* lds; int tid, lane, wave, G, bid, gw, ngw;
};
template <int MODE>
__device__ __forceinline__ void transpose_item(const float* W, int K, int N, bf16_t* WT, float scale, const float* gk, LAS float* scr, int item, int lane) {
    const int nblk = N / 32, kb = item / nblk, nb = item % nblk, k0 = 64 * kb, n0 = 32 * nb;
#pragma unroll 8
    for (int i = 0; i < 32; ++i) { const int kk = 2 * i + (lane >> 5); scr[kk * 33 + (lane & 31)] = __builtin_nontemporal_load(&W[(size_t)(k0 + kk) * N + n0 + (lane & 31)]); }
    LDS_WAIT(); asm volatile("" ::: "memory");
    const int c = lane & 7;
#pragma unroll
    for (int j = 0; j < 4; ++j) { const int n = (lane >> 3) + 8 * j; const LAS float* s = scr + (8 * c) * 33 + n;
        int no = n0 + n;
        if (MODE == 1) { const int h = no / DQK, w = no % DQK; const int w2 = (w < DNOPE) ? w : ((w < DNOPE + 32) ? DNOPE + 2 * (w - DNOPE) : DNOPE + 2 * (w - DNOPE - 32) + 1); no = h * DQK + w2; }
        float sc8[8];
#pragma unroll
        for (int q = 0; q < 8; ++q) sc8[q] = (MODE == 2) ? gk[k0 + 8 * c + q] : ((MODE == 1 && gk) ? scale * gk[k0 + 8 * c + q] : scale);
        u32x4 o; o.x = cvt_pk_bf16(s[0 * 33] * sc8[0], s[1 * 33] * sc8[1]); o.y = cvt_pk_bf16(s[2 * 33] * sc8[2], s[3 * 33] * sc8[3]);
        o.z = cvt_pk_bf16(s[4 * 33] * sc8[4], s[5 * 33] * sc8[5]); o.w = cvt_pk_bf16(s[6 * 33] * sc8[6], s[7 * 33] * sc8[7]);
        *(u32x4*)(WT + (size_t)no * K + k0 + 8 * c) = o; }
    LDS_WAIT(); asm volatile("" ::: "memory");
}
__device__ __forceinline__ void transpose_item_i8(const float* W, int K, int N, signed char* WT8, const float* gk, const unsigned* cmax, LAS float* scr, int item, int lane, int* csum = nullptr) {
    const int nblk = N / 32, kb = item / nblk, nb = item % nblk, k0 = 64 * kb, n0 = 32 * nb;
#pragma unroll 8
    for (int i = 0; i < 32; ++i) { const int kk = 2 * i + (lane >> 5); scr[kk * 33 + (lane & 31)] = __builtin_nontemporal_load(&W[(size_t)(k0 + kk) * N + n0 + (lane & 31)]); }
    LDS_WAIT(); asm volatile("" ::: "memory");
    const int c = lane & 7; float g8[8];
#pragma unroll
    for (int q = 0; q < 8; ++q) g8[q] = gk ? gk[k0 + 8 * c + q] : 1.f;
#pragma unroll
    for (int j = 0; j < 4; ++j) { const int n = (lane >> 3) + 8 * j; const LAS float* s = scr + (8 * c) * 33 + n; const int no = n0 + n;
        const float cm = __uint_as_float(cmax[no]), isc = cm > 0.f ? 127.f / cm : 0.f; int qv[8];
        int sm = 0;
#pragma unroll
        for (int q = 0; q < 8; ++q) { const float t = __builtin_rintf(s[q * 33] * g8[q] * isc); const int qi = (int)fminf(fmaxf(t, -127.f), 127.f); sm += qi; qv[q] = qi & 0xff; }
        if (csum) { sm += __shfl_xor(sm, 1); sm += __shfl_xor(sm, 2); sm += __shfl_xor(sm, 4); if (c == 0) atomicAdd(csum + no, sm); }
        u32x2 o; o.x = (unsigned)(qv[0] | (qv[1] << 8) | (qv[2] << 16) | (qv[3] << 24)); o.y = (unsigned)(qv[4] | (qv[5] << 8) | (qv[6] << 16) | (qv[7] << 24));
        *(u32x2*)(WT8 + (size_t)no * K + k0 + 8 * c) = o; }
    LDS_WAIT(); asm volatile("" ::: "memory");
}
__device__ __forceinline__ void convert_transpose_i8(const Ctx& F, const float* W, int K, int N, signed char* WT8, const float* gk, const unsigned* cmax, int* csum = nullptr) {
    LAS float* scr = (LAS float*)(F.lds + F.wave * 8704);
    const int nitems = (K / 64) * (N / 32);
    for (int it = F.gw; it < nitems; it += F.ngw) transpose_item_i8(W, K, N, WT8, gk, cmax, scr, it, F.lane, csum);
}
__device__ __forceinline__ void col_absmax(const Ctx& F, const float* W, int K, int N, const float* gk, unsigned* cmax) {
    const int nstrip = N / 256, nitems = (K / 64) * nstrip;
    for (int it = F.gw; it < nitems; it += F.ngw) { const int kb = it / nstrip, nb = it % nstrip; const float* p = W + (size_t)(kb * 64) * N + nb * 256 + F.lane * 4; f32x4 m = {0.f, 0.f, 0.f, 0.f};
#pragma unroll 16
        for (int k = 0; k < 64; ++k) { const f32x4 v = __builtin_nontemporal_load((const f32x4*)(p + (size_t)k * N)); const float g = gk ? fabsf(gk[kb * 64 + k]) : 1.f;
            m[0] = fmaxf(m[0], fabsf(v[0]) * g); m[1] = fmaxf(m[1], fabsf(v[1]) * g); m[2] = fmaxf(m[2], fabsf(v[2]) * g); m[3] = fmaxf(m[3], fabsf(v[3]) * g); }
        unsigned* q = cmax + nb * 256 + F.lane * 4;
#pragma unroll
        for (int e = 0; e < 4; ++e) atomicMax(q + e, __float_as_uint(m[e])); }
}
template <int MODE>
__device__ __forceinline__ void convert_transpose(const Ctx& F, const float* W, int K, int N, bf16_t* WT, float scale, const float* gk = nullptr) {
    LAS float* scr = (LAS float*)(F.lds + F.wave * 8704);
    const int nitems = (K / 64) * (N / 32);
    for (int it = F.gw; it < nitems; it += F.ngw) transpose_item<MODE>(W, K, N, WT, scale, gk, scr, it, F.lane);
}
__device__ __forceinline__ void convert_plain(const Ctx& F, const float* W, bf16_t* O, size_t n8) {
    for (size_t i = (size_t)F.bid * NTHR + F.tid; i < n8; i += (size_t)F.G * NTHR) {
        const f32x4 a = __builtin_nontemporal_load((const f32x4*)(W + i * 8)), b = __builtin_nontemporal_load((const f32x4*)(W + i * 8 + 4));
        u32x4 o; o.x = cvt_pk_bf16(a[0], a[1]); o.y = cvt_pk_bf16(a[2], a[3]); o.z = cvt_pk_bf16(b[0], b[1]); o.w = cvt_pk_bf16(b[2], b[3]);
        *(u32x4*)(O + i * 8) = o; }
}
template <bool OUTF32>
__device__ __forceinline__ void rms_row4096(const float* xrow, const float* g, void* orow, int lane) {
    const f32x4* xr = (const f32x4*)xrow + lane; f32x4 v[16]; float s = 0.f;
#pragma unroll
    for (int j = 0; j < 16; ++j) { v[j] = __builtin_nontemporal_load(xr + 64 * j); s += (v[j][0] * v[j][0] + v[j][1] * v[j][1]) + (v[j][2] * v[j][2] + v[j][3] * v[j][3]); }
    const float rstd = rsqrtf(wave_sum(s) * (1.f / DM) + NORM_EPS);
    const f32x4* gr = (const f32x4*)g + lane;
#pragma unroll
    for (int j = 0; j < 16; ++j) { const f32x4 gv = gr[64 * j]; const f32x4 o = v[j] * rstd * gv;
        if (OUTF32) ((f32x4*)orow)[lane + 64 * j] = o;
        else { u32x2 w; w.x = cvt_pk_bf16(o[0], o[1]); w.y = cvt_pk_bf16(o[2], o[3]); ((u32x2*)orow)[lane + 64 * j] = w; } }
}
__device__ __forceinline__ void rms_rows(const Ctx& F, const float* X, const float* g, bf16_t* O, int rows) {
    for (int m = F.gw; m < rows; m += F.ngw) rms_row4096<false>(X + (size_t)m * DM, g, O + (size_t)m * DM, F.lane);
}
__device__ __forceinline__ void sincos_rev(double r, float& s, float& c) {
    const double q = __builtin_rint(r * 4.0); const double y = (r - q * 0.25) * 6.283185307179586476925;
    const double y2 = y * y;
    const double sp = y * (1.0 + y2 * (-1.0 / 6 + y2 * (1.0 / 120 + y2 * (-1.0 / 5040 + y2 * (1.0 / 362880 + y2 * (-1.0 / 39916800 + y2 * (1.0 / 6227020800.0)))))));
    const double cp = 1.0 + y2 * (-0.5 + y2 * (1.0 / 24 + y2 * (-1.0 / 720 + y2 * (1.0 / 40320 + y2 * (-1.0 / 3628800 + y2 * (1.0 / 479001600.0 + y2 * (-1.0 / 87178291200.0)))))));
    const int qi = ((int)q) & 3;
    const double ss = (qi == 0) ? sp : (qi == 1) ? cp : (qi == 2) ? -sp : -cp;
    const double cc = (qi == 0) ? cp : (qi == 1) ? -sp : (qi == 2) ? -cp : sp;
    s = (float)ss; c = (float)cc;
}
__constant__ float INV_FREQ[32] = {1.000000000e+00f, 7.498942018e-01f, 5.623413324e-01f, 4.216965139e-01f, 3.162277639e-01f, 2.371373773e-01f, 1.778279394e-01f, 1.333521456e-01f,
    1.000000015e-01f, 7.498942316e-02f, 5.623413250e-02f, 4.216964915e-02f, 3.162277490e-02f, 2.371373773e-02f, 1.778279431e-02f, 1.333521400e-02f,
    9.999999776e-03f, 7.498942316e-03f, 5.623413250e-03f, 4.216964822e-03f, 3.162277630e-03f, 2.371373819e-03f, 1.778279431e-03f, 1.333521446e-03f,
    1.000000047e-03f, 7.498941850e-04f, 5.623413017e-04f, 4.216965172e-04f, 3.162277571e-04f, 2.371373703e-04f, 1.778279402e-04f, 1.333521504e-04f};

struct Args { const void* in[23]; float* out; unsigned char* ws; int ph_lo, ph_hi; };
constexpr int N_PHASES = 15;

__global__ void __launch_bounds__(NTHR, 2) mk_fwd(Args args) {
    extern __shared__ __attribute__((aligned(16))) unsigned char lds_raw[];
    Ctx F; F.lds = (LAS unsigned char*)lds_raw; F.tid = threadIdx.x; F.lane = F.tid & 63; F.wave = __builtin_amdgcn_readfirstlane(F.tid >> 6);
    F.G = gridDim.x; F.bid = blockIdx.x; F.gw = F.bid * NWAVES + F.wave; F.ngw = F.G * NWAVES;
    volatile LAS unsigned* MISC = (volatile LAS unsigned*)(F.lds + MISC_OFF);
    unsigned char* ws = args.ws;
    unsigned* ctl = (unsigned*)(ws + WS_CTL);
#define INP(i) ((const float*)args.in[i])
#define in_x INP(0)
#define in_mem INP(1)
#define positions ((const int*)args.in[2])
#define g_mix INP(3)
#define w_in INP(4)
#define w_fourier INP(5)
#define g_q_lora INP(6)
#define w_uq INP(7)
#define g_kv_lora INP(8)
#define w_ukv INP(9)
#define g_fourier_out INP(10)
#define g_mla_out INP(11)
#define w_out INP(12)
#define g_xattn INP(13)
#define g_mem INP(14)
#define w_xq INP(15)
#define w_xk INP(16)
#define w_xv INP(17)
#define w_xo INP(18)
#define g_mlp INP(19)
#define w_ff1 INP(20)
#define w_ff2 INP(21)
#define g_final INP(22)
#define hbuf (args.out)
#define WSP(T, off) ((T*)(ws + (off)))
#define ropec WSP(float, WS_ROPEC)
#define ropes WSP(float, WS_ROPES)
#define y4096 WSP(float, WS_Y4096)
#define tr4096 WSP(float, WS_TR4096)
#define trQ WSP(float, WS_TR4096 + 16384)
#define tiQ WSP(float, WS_TR4096 + 32768)
#define Zf4 WSP(bf16_t, WS_ZE)
#define CD4 WSP(bf16_t, WS_CT)
#define ssq1 WSP(float, WS_SSQ1)
#define ssq2 WSP(float, WS_SSQ2)
#define ssqq WSP(float, WS_SSQQ)
#define ssqkv WSP(float, WS_SSQKV)
#define hrmax WSP(unsigned, WS_SSQQ)
#define w1cmax WSP(unsigned, WS_SSQKV)
#define hrsc WSP(float, WS_RSTDX)
#define A8 WSP(signed char, WS_YA)
#define ysc WSP(float, WS_RSTDX)
#define wocmax WSP(unsigned, 48 * 1024)
#define Y8 WSP(signed char, WS_Y)
#define WoutT8 WSP(signed char, WS_WOUTT)
#define W1T8 ((signed char*)args.out)
#define rstdx WSP(float, WS_RSTDX)
#define XB ((bf16_t*)args.out)
#define Ze WSP(bf16_t, WS_ZE)
#define Zo WSP(bf16_t, WS_ZO)
#define memn WSP(bf16_t, WS_MEMN)
#define KVx WSP(bf16_t, WS_KX)
#define WuqT WSP(bf16_t, WS_WUQT)
#define WukvT WSP(bf16_t, WS_WUKVT)
#define MgT WSP(bf16_t, WS_MGT)
#define MT WSP(bf16_t, WS_MT)
#define NVT WSP(bf16_t, WS_NVT)
#define XN WSP(bf16_t, WS_XN)
#define TT WSP(bf16_t, WS_TT)
#define Cs WSP(bf16_t, WS_CS)
#define Ss WSP(bf16_t, WS_SS)
#define Y WSP(bf16_t, WS_Y)
#define Abuf WSP(bf16_t, WS_A)
#define zf WSP(bf16_t, WS_ZF)
#define cq WSP(bf16_t, WS_CQ)
#define ckv WSP(bf16_t, WS_CKV)
#define krope WSP(bf16_t, WS_KROPE)
#define Ct WSP(bf16_t, WS_CT)
#define Dt WSP(bf16_t, WS_DT)
#define WinT WSP(bf16_t, WS_WINT)
#define WxkT WSP(bf16_t, WS_WXKT)
#define WxvT WSP(bf16_t, WS_WXVT)
#define Qb WSP(bf16_t, WS_Q)
#define Kb WSP(bf16_t, WS_K)
#define Vb WSP(bf16_t, WS_V)
#define yA WSP(bf16_t, WS_YA)
#define Q8 WSP(signed char, WS_WXQ)
#define K8 WSP(signed char, WS_K)
#define krr WSP(unsigned, WS_K + 50 * MiB)
#define krmax WSP(float, WS_K + 53 * MiB)
#define q8s WSP(float, WS_WXQ + 96 * MiB)
#define k8s WSP(float, WS_K + 48 * MiB)
#define SC WSP(float, WS_SC)
#define WoutT WSP(bf16_t, WS_WOUTT)
#define Pb8 WSP(unsigned char, WS_P)
#define MT8 WSP(unsigned char, WS_MT)
#define NVT8 WSP(unsigned char, WS_NVT)
#define H8 WSP(unsigned char, WS_CT)
#define Wxq WSP(bf16_t, WS_WXQ)
#define WxoT WSP(bf16_t, WS_WXOT)
#define W1T ((bf16_t*)args.out)
#define W2T ((bf16_t*)args.out + (size_t)DFF * DM)
#define W2T8 ((signed char*)args.out + (size_t)128 * MiB)
#define A2_8 WSP(signed char, WS_YA)
#define armax WSP(unsigned, 384 * 1024)
#define w2csum WSP(int, 448 * 1024)
#define w2cmax WSP(unsigned, 48 * 1024)
#define a2sc WSP(float, WS_RSTDX)

    if (F.tid < 64) MISC[F.tid] = 0u;
    __syncthreads();
#if !MK_PER_PHASE
    XcdBarrier bar = xcd_barrier_post(ctl + CW_BAR, MISC + 8);
#define GRID_BAR() xcd_barrier(bar)
#else
#define GRID_BAR() do {} while (0)
#endif
    const int lo = args.ph_lo, hi = args.ph_hi;
#ifndef PH_MASK
#define PH_MASK 0x7fff
#endif
#define IN(k) (((PH_MASK >> (k)) & 1) && lo <= (k) && (k) < hi)
#ifndef PROBE_TS
#define PROBE_TS 0
#endif
#define STAMP(k) do { if (PROBE_TS && F.bid == 0 && F.tid == 0) { ((unsigned long long*)(ctl + 8192))[k] = __builtin_amdgcn_s_memrealtime(); ((unsigned long long*)(ctl + 8192))[32 + (k)] = __builtin_amdgcn_s_memtime(); } } while (0)
#define SEAM(k) do { if (IN((k) + 1)) GRID_BAR(); STAMP((k) + 1); } while (0)
#ifndef REP_MASK
#define REP_MASK 0
#endif
#define REPS(k) for (int rep_ = 0; rep_ <= ((REP_MASK >> (k)) & 1); ++rep_)
    const int G = F.G, cid = F.bid;
    STAMP(0);

    if (IN(0)) {
REPS(0) {
        REPS(16) {
        for (int m = F.gw; m < NTOK; m += F.ngw) {
            const f32x4* xr = (const f32x4*)(in_x + (size_t)m * DM) + F.lane; f32x4 v[16]; float sx = 0.f;
#pragma unroll
            for (int j = 0; j < 16; ++j) { v[j] = __builtin_nontemporal_load(xr + 64 * j); sx += (v[j][0] * v[j][0] + v[j][1] * v[j][1]) + (v[j][2] * v[j][2] + v[j][3] * v[j][3]); }
            sx = wave_sum(sx); if (F.lane == 0) rstdx[m] = rsqrtf(sx * (1.f / DM) + NORM_EPS);
#pragma unroll
            for (int j = 0; j < 16; ++j) { u32x2 w; w.x = cvt_pk_bf16(v[j][0], v[j][1]); w.y = cvt_pk_bf16(v[j][2], v[j][3]); ((u32x2*)(XB + (size_t)m * DM))[F.lane + 64 * j] = w; } }
        rms_rows(F, in_mem, g_mem, memn, NB * MEMT);
        }
        REPS(17) {
        convert_transpose<2>(F, w_in, DM, INW, WinT, 1.f, g_mix);
        for (size_t i = (size_t)F.bid * NTHR + F.tid; i < (size_t)(INWP - INW) * DM / 8; i += (size_t)G * NTHR) *(u32x4*)(WinT + (size_t)INW * DM + i * 8) = (u32x4){0u, 0u, 0u, 0u};
        convert_transpose<0>(F, w_xk, DM, DM, WxkT, 1.f);
        convert_transpose<0>(F, w_xv, DM, DM, WxvT, 1.f);
        convert_transpose<1>(F, w_uq, QR, NH * DQK, WuqT, 0.10411754627697264f);
        convert_transpose<0>(F, w_ukv, KVR, NH * (DNOPE + DV), WukvT, 1.f);
        }
        REPS(18) {
        for (int i = F.bid * NTHR + F.tid; i < NTOK * 32; i += G * NTHR) { const int t = i >> 5, j = i & 31;
            const float ang = (float)positions[t] * INV_FREQ[j];
            double r = (double)ang * 0.15915494309189533577; r -= __builtin_floor(r);
            float s, c; sincos_rev(r, s, c); ropec[i] = c; ropes[i] = s; }
        }
        REPS(19) {
        for (int i = F.bid * NTHR + F.tid; i < 4 * (SEQ / 4) * (SEQ / 32); i += G * NTHR) { const int zz = i / ((SEQ / 4) * (SEQ / 32)), k = (i / (SEQ / 32)) % (SEQ / 4), s0 = (i % (SEQ / 32)) * 8;
            const int kk = 2 * k + (zz & 1); const float sh = (zz >= 2) ? 0.25f : 0.f; unsigned cw[4];
#pragma unroll
            for (int j = 0; j < 4; ++j) { const float f0 = (float)((kk * (s0 + 2 * j)) & (SEQ - 1)) * (1.f / SEQ) - sh, f1 = (float)((kk * (s0 + 2 * j + 1)) & (SEQ - 1)) * (1.f / SEQ) - sh;
                cw[j] = cvt_pk_bf16(__builtin_amdgcn_cosf(f0), __builtin_amdgcn_cosf(f1)); }
            *(u32x4*)(Cs + (size_t)i * 8) = (u32x4){cw[0], cw[1], cw[2], cw[3]}; }
        }
        REPS(20) {
        for (int task = F.gw; task < FG * FC; task += F.ngw) { const int g = task >> 8, c = task & 255;
            const float* wf = w_fourier + (size_t)g * FC * FC + F.lane; float ar[4] = {0.f, 0.f, 0.f, 0.f}, ai[4] = {0.f, 0.f, 0.f, 0.f};
#pragma unroll 8
            for (int l = 0; l < FC; ++l) { const float f = (float)((l * c) & 255) * (1.f / 256.f); const float cs = __builtin_amdgcn_cosf(f), sn = __builtin_amdgcn_sinf(f);
#pragma unroll
                for (int j = 0; j < 4; ++j) { const float w = wf[(size_t)l * FC + 64 * j]; ar[j] += cs * w; ai[j] -= sn * w; } }
#pragma unroll
            for (int j = 0; j < 4; ++j) { const int d = F.lane + 64 * j;
                MgT[((size_t)g * 512 + d) * FC + c] = (bf16_t)(cvt_pk_bf16(ar[j] * 0.0625f, 0.f) & 0xffffu); MgT[((size_t)g * 512 + 256 + d) * FC + c] = (bf16_t)(cvt_pk_bf16(ai[j] * 0.0625f, 0.f) & 0xffffu); } }
        }
        }
        SEAM(0);
    }
    if (IN(1)) {
REPS(1) {
        { pg8::Order S; S.init(XB, DM, WinT, DM, NTOK / 256, INWP / 256, 1, 1, 0, 0, 0, 0, G, cid);
          pg8::EpiInProj E{zf, cq, ckv, krope, rstdx, ssqq, ssqkv}; pg8::gemm_phase(F.lds, DM, DM, DM, S, E); }
        { const int sh = ((NTOK / 256) * (INWP / 256)) % G; pg8::Order S; S.init(memn, DM, WxkT, DM, (NB * MEMT) / 256, 2 * DM / 256, 1, 1, 0, 0, 0, 0, G, (cid - sh + G) % G);
          pg8::EpiBf16Lin<0> E{KVx, 2 * DM, 1, 0, 0, (size_t)256 * 2 * DM, 256, 1.f};
          pg8::gemm_phase(F.lds, DM, DM, DM, S, E); }
        }
        SEAM(1);
    }
    if (IN(2)) {
        for (int t = F.gw; t < NTOK; t += F.ngw) {
            { u32x4* p = (u32x4*)(cq + (size_t)t * QR) + F.lane; u32x4 a = p[0], b = p[64]; float s = 0.f;
#pragma unroll
              for (int j = 0; j < 4; ++j) { const float a0 = bflo(a[j]), a1 = bfhi(a[j]), b0 = bflo(b[j]), b1 = bfhi(b[j]); s += a0 * a0 + a1 * a1 + b0 * b0 + b1 * b1; }
              const float rstd = rsqrtf(wave_sum(s) * (1.f / QR) + NORM_EPS);
              const f32x4* gp = (const f32x4*)g_q_lora + F.lane * 2; const f32x4 g0 = gp[0], g1 = gp[1], g2 = gp[128], g3 = gp[129];
              u32x4 oa, ob;
              oa.x = cvt_pk_bf16(bflo(a.x) * rstd * g0[0], bfhi(a.x) * rstd * g0[1]); oa.y = cvt_pk_bf16(bflo(a.y) * rstd * g0[2], bfhi(a.y) * rstd * g0[3]);
              oa.z = cvt_pk_bf16(bflo(a.z) * rstd * g1[0], bfhi(a.z) * rstd * g1[1]); oa.w = cvt_pk_bf16(bflo(a.w) * rstd * g1[2], bfhi(a.w) * rstd * g1[3]);
              ob.x = cvt_pk_bf16(bflo(b.x) * rstd * g2[0], bfhi(b.x) * rstd * g2[1]); ob.y = cvt_pk_bf16(bflo(b.y) * rstd * g2[2], bfhi(b.y) * rstd * g2[3]);
              ob.z = cvt_pk_bf16(bflo(b.z) * rstd * g3[0], bfhi(b.z) * rstd * g3[1]); ob.w = cvt_pk_bf16(bflo(b.w) * rstd * g3[2], bfhi(b.w) * rstd * g3[3]);
              p[0] = oa; p[64] = ob; }
            { u32x4* p = (u32x4*)(ckv + (size_t)t * KVR) + F.lane; u32x4 a = p[0]; float s = 0.f;
#pragma unroll
              for (int j = 0; j < 4; ++j) { const float a0 = bflo(a[j]), a1 = bfhi(a[j]); s += a0 * a0 + a1 * a1; }
              const float rstd = rsqrtf(wave_sum(s) * (1.f / KVR) + NORM_EPS);
              const f32x4* gp = (const f32x4*)g_kv_lora + F.lane * 2; const f32x4 g0 = gp[0], g1 = gp[1];
              u32x4 oa;
              oa.x = cvt_pk_bf16(bflo(a.x) * rstd * g0[0], bfhi(a.x) * rstd * g0[1]); oa.y = cvt_pk_bf16(bflo(a.y) * rstd * g0[2], bfhi(a.y) * rstd * g0[3]);
              oa.z = cvt_pk_bf16(bflo(a.z) * rstd * g1[0], bfhi(a.z) * rstd * g1[1]); oa.w = cvt_pk_bf16(bflo(a.w) * rstd * g1[2], bfhi(a.w) * rstd * g1[3]);
              p[0] = oa; }
            if (F.lane < 32) { const int p = F.lane; const float t1 = bf2f(krope[(size_t)t * DROPE + p]), t2 = bf2f(krope[(size_t)t * DROPE + 32 + p]);
              const float c = ropec[(size_t)t * 32 + p], s = ropes[(size_t)t * 32 + p];
              const unsigned w = cvt_pk_bf16(t1 * c - t2 * s, t1 * s + t2 * c);
              krr[(size_t)t * 32 + p] = w; float mx = fmaxf(fabsf(bflo(w)), fabsf(bfhi(w)));
#pragma unroll
              for (int o = 16; o > 0; o >>= 1) mx = fmaxf(mx, __shfl_xor(mx, o));
              if (p == 0) krmax[t] = mx; }
        }
        for (int col = F.gw; col < NB * FW; col += F.ngw) {
            const int b = col / FW, g = (col % FW) / FC, d = col % FC;
            const bf16_t* zb = zf + (size_t)b * SEQ * FW + g * FC;
            const u32x2 zh = *((const u32x2*)(zb + (size_t)(SEQ / 2) * FW) + F.lane), zq = *((const u32x2*)(zb + (size_t)(SEQ / 4) * FW) + F.lane), z3 = *((const u32x2*)(zb + (size_t)(3 * SEQ / 4) * FW) + F.lane);
            const u32x2 mr = *((const u32x2*)(MgT + ((size_t)g * 512 + d) * FC) + F.lane), mi = *((const u32x2*)(MgT + ((size_t)g * 512 + 256 + d) * FC) + F.lane);
            float sh = bflo(zh.x) * bflo(mr.x) + bfhi(zh.x) * bfhi(mr.x) + bflo(zh.y) * bflo(mr.y) + bfhi(zh.y) * bfhi(mr.y);
            float sq = (bflo(zq.x) + bflo(z3.x)) * bflo(mr.x) + (bfhi(zq.x) + bfhi(z3.x)) * bfhi(mr.x) + (bflo(zq.y) + bflo(z3.y)) * bflo(mr.y) + (bfhi(zq.y) + bfhi(z3.y)) * bfhi(mr.y);
            float si = (bflo(zq.x) - bflo(z3.x)) * bflo(mi.x) + (bfhi(zq.x) - bfhi(z3.x)) * bfhi(mi.x) + (bflo(zq.y) - bflo(z3.y)) * bflo(mi.y) + (bfhi(zq.y) - bfhi(z3.y)) * bfhi(mi.y);
            sh = wave_sum(sh); sq = wave_sum(sq); si = wave_sum(si); if (F.lane == 0) { tr4096[col] = sh; trQ[col] = sq; tiQ[col] = si; } }
        for (int r = F.gw; r < NB * (SEQ / 4); r += F.ngw) { const int b = r / (SEQ / 4), sx = r % (SEQ / 4); const bf16_t* zb = zf + (size_t)b * SEQ * FW;
            const u32x4* p1 = (const u32x4*)(zb + (size_t)sx * FW) + F.lane; const u32x4* p2 = (const u32x4*)(zb + (size_t)(sx ? SEQ - sx : 0) * FW) + F.lane;
            const u32x4* p3 = (const u32x4*)(zb + (size_t)(SEQ / 2 - sx) * FW) + F.lane; const u32x4* p4 = (const u32x4*)(zb + (size_t)(SEQ / 2 + sx) * FW) + F.lane;
            const size_t arr = (size_t)NB * (SEQ / 4) * FW;
#pragma unroll
            for (int j = 0; j < 4; ++j) { const u32x4 w1 = __builtin_nontemporal_load(p1 + 64 * j), w2 = __builtin_nontemporal_load(p2 + 64 * j), w3 = __builtin_nontemporal_load(p3 + 64 * j), w4 = __builtin_nontemporal_load(p4 + 64 * j); u32x4 o0, o1, o2, o3;
#pragma unroll
                for (int q = 0; q < 4; ++q) { float x1l = bflo(w1[q]), x1h = bfhi(w1[q]), x2l = bflo(w2[q]), x2h = bfhi(w2[q]), x3l = bflo(w3[q]), x3h = bfhi(w3[q]), x4l = bflo(w4[q]), x4h = bfhi(w4[q]);
                    if (sx == 0) { x2l = 0.f; x2h = 0.f; x3l = 0.f; x3h = 0.f; x4l = 0.f; x4h = 0.f; }
                    const float al = x1l + x2l, ah = x1h + x2h, bl = x3l + x4l, bh = x3h + x4h, cl = x1l - x2l, ch = x1h - x2h, dl = x3l - x4l, dh = x3h - x4h;
                    o0[q] = cvt_pk_bf16(al + bl, ah + bh); o1[q] = cvt_pk_bf16(al - bl, ah - bh);
                    o2[q] = (sx == 0) ? 0u : cvt_pk_bf16(cl - dl, ch - dh); o3[q] = (sx == 0) ? 0u : cvt_pk_bf16(cl + dl, ch + dh); }
                u32x4* po = (u32x4*)(Zf4 + (size_t)r * FW) + F.lane + 64 * j;
                po[0] = o0; *(u32x4*)((bf16_t*)po + arr) = o1; *(u32x4*)((bf16_t*)po + 2 * arr) = o2; *(u32x4*)((bf16_t*)po + 3 * arr) = o3; } }
        convert_plain(F, w_xq, Wxq, (size_t)DM * DM / 8);
        convert_transpose<0>(F, w_xo, DM, DM, WxoT, 1.f);
        convert_transpose<0>(F, w_out, DM, DM, WoutT, 1.f);
        SEAM(2);
    }
    if (IN(3)) {
REPS(3) {
#ifndef P3M
#define P3M 31
#endif
        if (P3M & 1) {
#pragma unroll
          for (int e = 0; e < 2; ++e) { const size_t arr = (size_t)NB * (SEQ / 4) * FW;
            pg8::Order S; S.init(MgT, FC, Zf4 + e * arr, FW, 2, (SEQ / 4) / 256, NB, FG, 0, (size_t)512 * FC * 2, (size_t)(SEQ / 4) * FW * 2, (size_t)FC * 2, G, cid); S.pmB = 2 * arr * 2;
            pg8::EpiBf16Lin<0> E{TT + e * (SEQ / 4), SEQ, 1, (size_t)256 * SEQ, 0, (size_t)(SEQ / 2), 256, 1.f}; pg8::gemm_phase(F.lds, FC, FC, FW, S, E); } }
        if (P3M & 2) { pg8::Order S; S.init(cq, QR, WuqT, QR, NTOK / 256, (NH * DQK) / 256, 1, 1, 0, 0, 0, 0, G, cid);
          pg8::EpiQ E{Qb, ropec, ropes, ssqq}; pg8::gemm_phase(F.lds, QR, QR, QR, S, E); }
        if (P3M & 4) { pg8::Order S; S.init(ckv, KVR, WukvT, KVR, NTOK / 256, NH, 1, 1, 0, 0, 0, 0, G, cid);
          pg8::EpiKV8 E{K8, k8s, Vb, krr, krmax, (LAS float*)(F.lds + MISC_OFF + 1024)}; pg8::gemm_phase(F.lds, KVR, KVR, KVR, S, E); }
        if (P3M & 8) {
          pg8::Order S; S.init(KVx, 2 * DM, Wxq, DM, 1, DM / 256, NB, XH, (size_t)MEMT * 2 * DM * 2, (size_t)XHD * 2, 0, (size_t)XHD * 2, G, cid);
          pg8::EpiF8ColGain E{MT8, g_xattn, DM, XH, (size_t)XH * MEMT * DM, (size_t)MEMT * DM, 0, 256}; pg8::gemm_phase(F.lds, XHD, 2 * DM, DM, S, E); }
        if (P3M & 16) {
          const int sh = (NB * XH * (DM / 256)) % G; pg8::Order S; S.init(WxoT, DM, KVx + DM, 2 * DM, DM / 256, 1, NB, XH, 0, (size_t)XHD * 2, (size_t)MEMT * 2 * DM * 2, (size_t)XHD * 2, G, (cid - sh + G) % G);
          pg8::EpiF8Lin E{NVT8, XH * MEMT, XH, (size_t)DM * XH * MEMT, (size_t)MEMT, (size_t)256 * XH * MEMT, 0}; pg8::gemm_phase(F.lds, XHD, DM, 2 * DM, S, E); }
        }
        SEAM(3);
    }
    if (IN(4)) {
REPS(4) {
        for (int i = 0;; ++i) { const int L = i * G + cid; if (L >= NB * NH * (SEQ / 256)) break;
            int bh, qb; if (G == 256) { bh = i * 8 + (cid & 7); qb = cid >> 3; } else { bh = L / (SEQ / 256); qb = L % (SEQ / 256); }
            const int b = bh / NH, h = bh % NH; const size_t t0 = (size_t)b * SEQ;
            att8::attn_body8(Qb + (t0 + (size_t)qb * 256) * (NH * DQK) + h * DQK, K8 + (size_t)bh * SEQ * DQK, k8s + (size_t)bh * (SEQ / 32), Vb + t0 * (NH * DV) + h * DV,
                           yA + (t0 + (size_t)qb * 256) * FW + h * DV, SEQ, F.lds); }
        }
STAMP(20);
REPS(15) {
        {
          pg8::Order S; S.init(Cs, SEQ / 4, TT, SEQ, (SEQ / 4) / 256, (NB * FW) / 256, 4, 1, (size_t)(SEQ / 4) * (SEQ / 4) * 2, 0, (size_t)(SEQ / 4) * 2, 0, G, cid);
          pg8::EpiBf16Lin<0> E{CD4, NB * FW, 1, (size_t)(SEQ / 4) * NB * FW, 0, (size_t)256 * NB * FW, 256, 1.f}; pg8::gemm_phase(F.lds, SEQ / 4, SEQ / 4, SEQ, S, E); }
        }
        for (int col = F.gw; col < NB * FW; col += F.ngw) {
            const u32x4* p = (const u32x4*)(TT + (size_t)col * SEQ) + F.lane; float sa = 0.f;
#pragma unroll 4
            for (int j = 0; j < SEQ / 2048; ++j) { const u32x4 v = p[64 * j];
#pragma unroll
                for (int q = 0; q < 4; ++q) sa += bflo(v[q]) - bfhi(v[q]); }
            sa = wave_sum(sa); if (F.lane == 0) y4096[col] = sa + trQ[col] + tr4096[col]; }
        SEAM(4);
    }
    if (IN(5)) {
REPS(5) {
        const float isq = 0.011048543456039804f;
        for (int t = F.gw; t < NTOK; t += F.ngw) { const int b = t / SEQ, s = t % SEQ; const int k = (s <= SEQ / 2) ? s : SEQ - s; const float sg = (s <= SEQ / 2) ? 1.f : -1.f;
            f32x4 v[8]; float ss = 0.f;
#pragma unroll
            for (int j = 0; j < 4; ++j) { const int col = F.lane * 8 + 512 * j;
                if (s == SEQ / 2) { v[2 * j] = *(const f32x4*)(y4096 + b * FW + col) * isq; v[2 * j + 1] = *(const f32x4*)(y4096 + b * FW + col + 4) * isq; }
                else { const int k2 = k >> 1, odd = k & 1; const size_t zs = (size_t)(SEQ / 4) * NB * FW; const size_t ro = (size_t)k2 * (NB * FW) + b * FW + col;
                    const u32x4 c = *(const u32x4*)(CD4 + (odd ? zs : 0) + ro), d = *(const u32x4*)(CD4 + (odd ? 3 * zs : 2 * zs) + ro);
                    const float pk2 = (k2 & 1) ? -1.f : 1.f, pkh = odd ? -1.f : 1.f;
                    const float* rq = odd ? tiQ : trQ;
                    const f32x4 q0 = *(const f32x4*)(rq + b * FW + col) * pk2, q1 = *(const f32x4*)(rq + b * FW + col + 4) * pk2;
                    const f32x4 t0 = *(const f32x4*)(tr4096 + b * FW + col) * pkh, t1 = *(const f32x4*)(tr4096 + b * FW + col + 4) * pkh;
                    f32x4 c0 = (f32x4){bflo(c.x), bfhi(c.x), bflo(c.y), bfhi(c.y)}, c1 = (f32x4){bflo(c.z), bfhi(c.z), bflo(c.w), bfhi(c.w)};
                    f32x4 d0 = (f32x4){bflo(d.x), bfhi(d.x), bflo(d.y), bfhi(d.y)}, d1 = (f32x4){bflo(d.z), bfhi(d.z), bflo(d.w), bfhi(d.w)};
                    if (odd) { d0 += q0; d1 += q1; } else { c0 += q0; c1 += q1; }
                    v[2 * j] = (c0 + t0 + d0 * sg) * isq; v[2 * j + 1] = (c1 + t1 + d1 * sg) * isq; }
#pragma unroll
                for (int q = 0; q < 2; ++q) { const f32x4 w = v[2 * j + q]; ss += (w[0] * w[0] + w[1] * w[1]) + (w[2] * w[2] + w[3] * w[3]); } }
            const float rstd = rsqrtf(wave_sum(ss) * (1.f / FW) + NORM_EPS); float mx = 0.f;
#pragma unroll
            for (int j = 0; j < 4; ++j) { const int col = F.lane * 8 + 512 * j; const f32x4 g0 = *(const f32x4*)(g_fourier_out + col), g1 = *(const f32x4*)(g_fourier_out + col + 4);
                v[2 * j] = v[2 * j] * rstd * g0; v[2 * j + 1] = v[2 * j + 1] * rstd * g1;
#pragma unroll
                for (int q = 0; q < 2; ++q) { const f32x4 w = v[2 * j + q]; mx = fmaxf(mx, fmaxf(fmaxf(fabsf(w[0]), fabsf(w[1])), fmaxf(fabsf(w[2]), fabsf(w[3])))); } }
            u32x4 a[4]; float sa = 0.f;
#pragma unroll
            for (int j = 0; j < 4; ++j) { a[j] = __builtin_nontemporal_load((const u32x4*)(yA + (size_t)t * FW + F.lane * 8 + 512 * j));
#pragma unroll
                for (int q = 0; q < 4; ++q) { const float x0 = bflo(a[j][q]), x1 = bfhi(a[j][q]); sa += x0 * x0 + x1 * x1; } }
            const float rsa = rsqrtf(wave_sum(sa) * (1.f / FW) + NORM_EPS);
            f32x4 ya[8];
#pragma unroll
            for (int j = 0; j < 4; ++j) { const int col = F.lane * 8 + 512 * j; const f32x4 g0 = *(const f32x4*)(g_mla_out + col), g1 = *(const f32x4*)(g_mla_out + col + 4);
                ya[2 * j] = (f32x4){bflo(a[j].x), bfhi(a[j].x), bflo(a[j].y), bfhi(a[j].y)} * rsa * g0; ya[2 * j + 1] = (f32x4){bflo(a[j].z), bfhi(a[j].z), bflo(a[j].w), bfhi(a[j].w)} * rsa * g1;
#pragma unroll
                for (int q = 0; q < 2; ++q) { const f32x4 w = ya[2 * j + q]; mx = fmaxf(mx, fmaxf(fmaxf(fabsf(w[0]), fabsf(w[1])), fmaxf(fabsf(w[2]), fabsf(w[3])))); } }
#pragma unroll
            for (int j = 0; j < 4; ++j) { const int col = F.lane * 8 + 512 * j;
#pragma unroll
                for (int hf = 0; hf < 2; ++hf) { const f32x4 p0 = hf ? ya[2 * j] : v[2 * j], p1 = hf ? ya[2 * j + 1] : v[2 * j + 1];
                    u32x4 w; w.x = cvt_pk_bf16(p0[0], p0[1]); w.y = cvt_pk_bf16(p0[2], p0[3]); w.z = cvt_pk_bf16(p1[0], p1[1]); w.w = cvt_pk_bf16(p1[2], p1[3]);
                    *(u32x4*)(Y + (size_t)t * DM + hf * FW + col) = w; } }
        }
        }
        SEAM(5);
    }
    if (IN(6)) {
REPS(6) {
        pg8::Order S; S.init(Y, DM, WoutT, DM, NTOK / 256, DM / 256, 1, 1, 0, 0, 0, 0, G, cid);
        pg8::EpiResB<false, true> E{XB, XN, ssq1, DM, 0, H8, nullptr, nullptr, nullptr, nullptr, 1.f}; pg8::gemm_phase(F.lds, DM, DM, DM, S, E);
        }
        SEAM(6);
    }
    if (IN(8)) {
REPS(8) {
        pg8::Order S; S.init(H8, DM / 2, MT8, DM / 2, SEQ / 256, (XH * MEMT) / 256, NB, 1, (size_t)SEQ * DM, 0, (size_t)XH * MEMT * DM, 0, G, cid);
        pg8::EpiSoftmax E{Pb8, ssq1, XH * MEMT, 0.03125f, SEQ, (LAS float*)(F.lds + MISC_OFF + 1024)}; pg8::gemm_phase<true>(F.lds, DM / 2, DM / 2, DM / 2, S, E);
        }
        col_absmax(F, w_ff2, DFF, DM, nullptr, w2cmax);
        col_absmax(F, w_ff1, DM, DFF, g_mlp, w1cmax);
        SEAM(8);
    }
    if (IN(10)) {
        pg8::Order S; S.init(Pb8, (XH * MEMT) / 2, NVT8, (XH * MEMT) / 2, SEQ / 256, DM / 256, NB, 1, (size_t)SEQ * XH * MEMT, 0, (size_t)DM * XH * MEMT, 0, G, cid);
        pg8::EpiResB<false, true> E{XN, XN, ssq2, DM, SEQ, nullptr, nullptr, nullptr, nullptr, nullptr, 1.f / 256.f}; pg8::gemm_phase<true>(F.lds, (XH * MEMT) / 2, (XH * MEMT) / 2, (XH * MEMT) / 2, S, E);
        convert_transpose_i8(F, w_ff1, DM, DFF, W1T8, g_mlp, w1cmax);
        convert_transpose_i8(F, w_ff2, DFF, DM, W2T8, nullptr, w2cmax, w2csum);
        SEAM(10);
    }
    if (IN(11)) {
        for (int m = F.gw; m < NTOK; m += F.ngw) {
            const u32x4* hr = (const u32x4*)(XN + (size_t)m * DM) + F.lane; u32x4 v[8]; float rm = 0.f;
#pragma unroll
            for (int j = 0; j < 8; ++j) { v[j] = hr[64 * j];
#pragma unroll
                for (int e = 0; e < 4; ++e) rm = fmaxf(rm, fmaxf(fabsf(bflo(v[j][e])), fabsf(bfhi(v[j][e])))); }
#pragma unroll
            for (int o = 32; o > 0; o >>= 1) rm = fmaxf(rm, __shfl_xor(rm, o));
            const float isc = rm > 0.f ? 127.f / rm : 0.f;
            if (F.lane == 0) hrsc[m] = rm * (1.f / 127.f) * rsqrtf(ssq2[m] * (1.f / DM) + NORM_EPS);
#pragma unroll
            for (int j = 0; j < 8; ++j) { int q[8];
#pragma unroll
                for (int e = 0; e < 4; ++e) { q[2 * e] = (int)__builtin_rintf(bflo(v[j][e]) * isc) & 0xff; q[2 * e + 1] = (int)__builtin_rintf(bfhi(v[j][e]) * isc) & 0xff; }
                u32x2 o; o.x = (unsigned)(q[0] | (q[1] << 8) | (q[2] << 16) | (q[3] << 24)); o.y = (unsigned)(q[4] | (q[5] << 8) | (q[6] << 16) | (q[7] << 24));
                ((u32x2*)(A8 + (size_t)m * DM))[F.lane + 64 * j] = o; } }
        SEAM(11);
    }
    if (IN(12)) {
#if (REP_MASK >> 21) & 1
        {
            pg8::Order S; S.init(XN, DM, W1T, DM, NTOK / 256, DFF / 256, 1, 1, 0, 0, 0, 0, G, cid); S.tA = 0; S.tB = 0;
            pg8::EpiBf16Lin<1> E{(bf16_t*)(ws + WS_END) + (size_t)cid * 65536, 256, 1, 0, 0, 0, 0, 1.f}; pg8::gemm_phase(F.lds, DM, DM, DM, S, E); }
#endif
REPS(12) {
        pg8::Order S; S.init(A8, DM / 2, W1T8, DM / 2, NTOK / 256, DFF / 256, 1, 1, 0, 0, 0, 0, G, cid);
        pg8::EpiFFN1 E{Abuf, hrsc, (const float*)w1cmax, armax, DFF}; pg8::gemm_phase<2>(F.lds, DM / 2, DM / 2, DM / 2, S, E);
        }
        SEAM(12);
    }
    if (IN(13)) {
#if (REP_MASK >> 22) & 1
        {
            pg8::Order S; S.init(Abuf, DFF, W2T, DFF, NTOK / 256, DM / 256, 1, 1, 0, 0, 0, 0, G, cid);
            pg8::EpiBf16Lin<0> E{(bf16_t*)(ws + WS_END) + (size_t)cid * 65536, 256, 1, 0, 0, 0, 0, 1.f}; pg8::gemm_phase(F.lds, DFF, DFF, DFF, S, E); }
#endif
        for (int t = F.gw; t < NTOK; t += F.ngw) {
            const u32x4* src = (const u32x4*)(Abuf + (size_t)t * DFF) + F.lane; u32x2* dst = (u32x2*)(A2_8 + (size_t)t * DFF) + F.lane; constexpr int NALL = DFF / 512, NH2 = (NALL * 3) / 4; u32x4 v[NH2]; float am = 0.f;
#pragma unroll
            for (int i = 0; i < NH2; ++i) v[i] = src[64 * i];
#pragma unroll 8
            for (int i = NH2; i < NALL; ++i) { const u32x4 w = src[64 * i];
#pragma unroll
                for (int e = 0; e < 4; ++e) am = fmaxf(am, fmaxf(bflo(w[e]), bfhi(w[e]))); }
#pragma unroll
            for (int i = 0; i < NH2; ++i)
#pragma unroll
                for (int e = 0; e < 4; ++e) am = fmaxf(am, fmaxf(bflo(v[i][e]), bfhi(v[i][e])));
#pragma unroll
            for (int o = 32; o > 0; o >>= 1) am = fmaxf(am, __shfl_xor(am, o));
            const float isc = am > 0.f ? 255.f / am : 0.f; if (F.lane == 0) a2sc[t] = am * (1.f / 255.f);
#define A8CODES(W, I) do { int q[8]; _Pragma("unroll") for (int e = 0; e < 4; ++e) { q[2 * e] = ((int)__builtin_rintf(bflo(W[e]) * isc) - 128) & 0xff; q[2 * e + 1] = ((int)__builtin_rintf(bfhi(W[e]) * isc) - 128) & 0xff; } \
                u32x2 o; o.x = (unsigned)(q[0] | (q[1] << 8) | (q[2] << 16) | (q[3] << 24)); o.y = (unsigned)(q[4] | (q[5] << 8) | (q[6] << 16) | (q[7] << 24)); dst[64 * (I)] = o; } while (0)
#pragma unroll
            for (int i = 0; i < NH2; ++i) A8CODES(v[i], i);
#pragma unroll 8
            for (int i = NH2; i < NALL; ++i) { const u32x4 w = __builtin_nontemporal_load(src + 64 * i); A8CODES(w, i); }
#undef A8CODES
        }
        GRID_BAR();
        pg8::Order S; S.init(A2_8, DFF / 2, W2T8, DFF / 2, NTOK / 256, DM / 256, 1, 1, 0, 0, 0, 0, G, cid);
        pg8::EpiResB<false, false> E{XN, XN, nullptr, DM, 0, nullptr, nullptr, a2sc, (const float*)w2cmax, w2csum, 1.f}; pg8::gemm_phase<2>(F.lds, DFF / 2, DFF / 2, DFF / 2, S, E);
        SEAM(13);
    }
    if (IN(14)) {
        for (int m = F.gw; m < NTOK; m += F.ngw) {
            const u32x4* hr = (const u32x4*)(XN + (size_t)m * DM) + F.lane; u32x4 v[8]; float ss = 0.f;
#pragma unroll
            for (int j = 0; j < 8; ++j) { v[j] = __builtin_nontemporal_load(hr + 64 * j);
#pragma unroll
                for (int q = 0; q < 4; ++q) { const float a = bflo(v[j][q]), b = bfhi(v[j][q]); ss += a * a + b * b; } }
            const float rstd = rsqrtf(wave_sum(ss) * (1.f / DM) + NORM_EPS);
#pragma unroll
            for (int j = 0; j < 8; ++j) { const int col = (F.lane + 64 * j) * 8; const f32x4 g0 = *(const f32x4*)(g_final + col), g1 = *(const f32x4*)(g_final + col + 4);
                f32x4 o0 = (f32x4){bflo(v[j].x), bfhi(v[j].x), bflo(v[j].y), bfhi(v[j].y)} * rstd * g0, o1 = (f32x4){bflo(v[j].z), bfhi(v[j].z), bflo(v[j].w), bfhi(v[j].w)} * rstd * g1;
                *(f32x4*)(hbuf + (size_t)m * DM + col) = o0; *(f32x4*)(hbuf + (size_t)m * DM + col + 4) = o1; } }
    }
#if PROBE_TS
    STAMP(15);
    if (F.bid == 0) { VM_WAIT(); __syncthreads();
        const unsigned long long* ts = (const unsigned long long*)(ctl + 8192);
#if defined(PROBE_CLK)
        const float V = __builtin_floorf((float)(long long)(ts[32 + PROBE_A1] - ts[32 + PROBE_A0]) / (float)(long long)(ts[PROBE_A1] - ts[PROBE_A0]) * 0.5f + 0.5f);
#else
        const float V = __builtin_floorf((float)(long long)(ts[PROBE_A1] - ts[PROBE_A0]) * 0.01f / (float)PROBE_BIN + 0.5f);
#endif
        for (int i = F.tid; i < 4096; i += NTHR) hbuf[DM + i] = V; }
#endif
#undef IN
#undef SEAM
#undef GRID_BAR
}


extern "C" void kernel_launch(void* const* d_in, const int* in_sizes, int n_in, void* d_out, int out_size, void* d_ws, size_t ws_size, hipStream_t stream) {
    static int grid = 0;
    if (grid == 0) {
        if (n_in != 23 || in_sizes[0] != NTOK * DM || out_size != NTOK * DM || ws_size < WS_END) {
            fprintf(stderr, "kernel_launch: shape/workspace mismatch: n_in %d in0 %d out %d ws %zu (need >= %zu)\n", n_in, n_in > 0 ? in_sizes[0] : -1, out_size, ws_size, (size_t)WS_END); grid = -1; return; }
        int dev = 0, cus = 0, per_cu = 0;
        if (hipGetDevice(&dev) != hipSuccess || hipDeviceGetAttribute(&cus, hipDeviceAttributeMultiprocessorCount, dev) != hipSuccess) { fprintf(stderr, "kernel_launch: device query failed\n"); grid = -1; return; }
        if (hipFuncSetAttribute((const void*)mk_fwd, hipFuncAttributeMaxDynamicSharedMemorySize, LDS_BYTES) != hipSuccess) { fprintf(stderr, "kernel_launch: hipFuncSetAttribute failed\n"); grid = -1; return; }
        if (hipOccupancyMaxActiveBlocksPerMultiprocessor(&per_cu, (const void*)mk_fwd, NTHR, LDS_BYTES) != hipSuccess || per_cu < 1) {
            fprintf(stderr, "kernel_launch: occupancy query reports %d workgroups per CU\n", per_cu); }
        (void)hipGetLastError();
        grid = cus;
    }
    if (grid < 0) return;
    if (hipMemsetAsync((char*)d_ws + WS_CTL, 0, CTL_ZERO_BYTES, stream) != hipSuccess) { fprintf(stderr, "kernel_launch: memset failed\n"); return; }
    Args a{};
    for (int i = 0; i < 23; ++i) a.in[i] = d_in[i];
    a.out = (float*)d_out; a.ws = (unsigned char*)d_ws;
#if MK_PER_PHASE
#ifndef DBG_STOP
#define DBG_STOP N_PHASES
#endif
    for (int p = 0; p < DBG_STOP; ++p) { a.ph_lo = p; a.ph_hi = p + 1; hipLaunchKernelGGL(mk_fwd, dim3(grid), dim3(NTHR), LDS_BYTES, stream, a); }
#else
    a.ph_lo = 0; a.ph_hi = N_PHASES; hipLaunchKernelGGL(mk_fwd, dim3(grid), dim3(NTHR), LDS_BYTES, stream, a);
#endif
    const hipError_t le = hipPeekAtLastError();
    if (le != hipSuccess) fprintf(stderr, "kernel_launch: launch failed: %s\n", hipGetErrorName(le));
}
```

```cpp
#include <hip/hip_runtime.h>
#include <cstdio>
#include <cstdint>

#ifndef MK_PER_PHASE
#define MK_PER_PHASE 0
#endif

#define LAS __attribute__((address_space(3)))
#define GAS __attribute__((address_space(1)))
typedef unsigned short bf16_t;
typedef short bf16x8 __attribute__((ext_vector_type(8)));
typedef short s16x4 __attribute__((ext_vector_type(4)));
typedef float f32x2 __attribute__((ext_vector_type(2)));
typedef float f32x4 __attribute__((ext_vector_type(4)));
typedef float f32x16 __attribute__((ext_vector_type(16)));
typedef unsigned u32x2 __attribute__((ext_vector_type(2)));
typedef unsigned u32x4 __attribute__((ext_vector_type(4)));

constexpr int DM = 4096, NB = 2, SEQ = 8192, NTOK = NB * SEQ;
constexpr int FW = 2048, FG = 8, FC = 256;
constexpr int NH = 16, DNOPE = 128, DROPE = 64, DV = 128, DQK = 192;
constexpr int QR = 1024, KVR = 512, INW = 3648, INWP = 3840;
constexpr int MEMT = 256, XH = 4, XHD = 1024;
constexpr int DFF = 16384;
constexpr float NORM_EPS = 1e-6f;
constexpr int NWAVES = 8, NTHR = 512;

constexpr size_t MiB = 1ull << 20;
constexpr size_t WS_CTL = 0, CTL_ZERO_BYTES = 512 * 1024, WS_SSQ1 = 64 * 1024, WS_SSQ2 = 128 * 1024, WS_SSQQ = 192 * 1024, WS_SSQKV = 256 * 1024, WS_RSTDX = 320 * 1024;
constexpr size_t WS_ROPEC = 1 * MiB, WS_ROPES = 3 * MiB, WS_Y4096 = 5 * MiB, WS_MEMN = 6 * MiB, WS_KX = 10 * MiB, WS_VX = 14 * MiB;
constexpr size_t WS_WUQT = 18 * MiB, WS_WUKVT = 24 * MiB, WS_MGT = 28 * MiB, WS_MT = 30 * MiB, WS_NVT = 46 * MiB;
constexpr size_t WS_XN = 64 * MiB, WS_TT = 64 * MiB, WS_ZE = 128 * MiB, WS_ZO = 160 * MiB;
constexpr size_t WS_TR4096 = 5 * MiB + 65536;
constexpr size_t WS_CS = 192 * MiB, WS_SS = 224 * MiB, WS_Y = 192 * MiB, WS_A = 192 * MiB;
constexpr size_t WS_ZF = 320 * MiB, WS_CQ = 384 * MiB, WS_CKV = 416 * MiB, WS_KROPE = 432 * MiB, WS_CT = 320 * MiB, WS_DT = 384 * MiB;
constexpr size_t WS_WINT = 448 * MiB, WS_WXKT = 480 * MiB, WS_WXVT = 512 * MiB, WS_Q = 448 * MiB, WS_K = 544 * MiB, WS_V = 640 * MiB;
constexpr size_t WS_YA = 704 * MiB, WS_SC = 704 * MiB, WS_WOUTT = 768 * MiB, WS_P = 800 * MiB, WS_WXQ = 832 * MiB, WS_WXOT = 864 * MiB;
constexpr size_t WS_W1T = 704 * MiB, WS_W2T = 832 * MiB, WS_END = 960 * MiB;
constexpr int CW_BAR = 4096;

constexpr int RING_BYTES = 131072;
constexpr int MISC_OFF = RING_BYTES;
constexpr int LDS_BYTES = RING_BYTES + 1024 + 8192;

typedef __bf16 bf16x2_t __attribute__((ext_vector_type(2)));
__device__ __forceinline__ unsigned cvt_pk_bf16(float lo, float hi) { const f32x2 v = {lo, hi}; const bf16x2_t r = __builtin_convertvector(v, bf16x2_t); return __builtin_bit_cast(unsigned, r); }
__device__ __forceinline__ u32x2 cvt_pk8_fp8(f32x4 a, f32x4 b) { unsigned w0 = 0u, w1 = 0u;
    w0 = __builtin_amdgcn_cvt_pk_fp8_f32(a[0], a[1], w0, false); w0 = __builtin_amdgcn_cvt_pk_fp8_f32(a[2], a[3], w0, true);
    w1 = __builtin_amdgcn_cvt_pk_fp8_f32(b[0], b[1], w1, false); w1 = __builtin_amdgcn_cvt_pk_fp8_f32(b[2], b[3], w1, true); return (u32x2){w0, w1}; }
__device__ __forceinline__ float bf2f(unsigned short b) { return __uint_as_float(((unsigned)b) << 16); }
__device__ __forceinline__ float bflo(unsigned w) { return __uint_as_float(w << 16); }
__device__ __forceinline__ float bfhi(unsigned w) { return __uint_as_float(w & 0xffff0000u); }
__device__ __forceinline__ float wave_sum(float v) {
#pragma unroll
    for (int o = 1; o < 64; o <<= 1) v += __shfl_xor(v, o);
    return v;
}
__device__ __forceinline__ float wave_max(float v) {
#pragma unroll
    for (int o = 1; o < 64; o <<= 1) v = fmaxf(v, __shfl_xor(v, o));
    return v;
}
#define LDS_WAIT() asm volatile("s_waitcnt lgkmcnt(0)" ::: "memory")
#define VM_WAIT() asm volatile("s_waitcnt vmcnt(0)" ::: "memory")

#define XB_TMO      128
#define XB_XCNT(j)  (256  + 64 * (j))
#define XB_XSUB(j)  (1280 + 64 * (j))
#define XB_XGEN(j)  (2304 + 64 * (j))
#define XB_TOP      3328
#define XB_TOPGEN   3392
#define XCD_BAR_WORDS 3456
#define XB_SPIN_CAP (1u << 18)
__device__ __forceinline__ unsigned xb_ld(unsigned* p)              { return __hip_atomic_load(p, __ATOMIC_RELAXED, __HIP_MEMORY_SCOPE_AGENT); }
__device__ __forceinline__ unsigned xb_add(unsigned* p, unsigned v) { return __hip_atomic_fetch_add(p, v, __ATOMIC_RELAXED, __HIP_MEMORY_SCOPE_AGENT); }
__device__ __forceinline__ unsigned xb_xcc_id() { return (unsigned)__builtin_amdgcn_s_getreg((3 << 11) | 20) & 0xFu; }
#define XB_SPIN(cond, bar) do { unsigned _sp = 0; while (cond) { __builtin_amdgcn_s_sleep(1); \
    if ((++_sp & 255u) == 0u) { if (xb_ld(&(bar)[XB_TMO])) break; if (_sp > XB_SPIN_CAP) { atomicAdd(&(bar)[XB_TMO], 1u); break; } } } } while (0)
struct XcdBarrier { unsigned* bar; unsigned x; volatile LAS unsigned* st; };
__device__ __forceinline__ XcdBarrier xcd_barrier_post(unsigned* bar, volatile LAS unsigned* st) {
    XcdBarrier b; b.bar = bar; b.x = xb_xcc_id(); b.st = st;
    if (threadIdx.x == 0) (void)xb_add(&bar[XB_XCNT(b.x)], 1u);
    return b;
}
__device__ __forceinline__ void xcd_barrier_complete(unsigned* bar, unsigned x, unsigned& nloc, unsigned& nx) {
    const unsigned G = gridDim.x * gridDim.y * gridDim.z;
    unsigned sum, cnt, mine, sp = 0u;
    for (;;) {
        sum = 0u; cnt = 0u; mine = 0u;
#pragma unroll
        for (unsigned j = 0; j < 16; ++j) { const unsigned c = xb_ld(&bar[XB_XCNT(j)]); sum += c; cnt += (c > 0u) ? 1u : 0u; mine = (j == x) ? c : mine; }
        if (sum == G) break;
        __builtin_amdgcn_s_sleep(1);
        if ((++sp & 255u) == 0u) { if (xb_ld(&bar[XB_TMO])) break; if (sp > XB_SPIN_CAP) { atomicAdd(&bar[XB_TMO], 1u); break; } }
    }
    nloc = mine > 0u ? mine : 1u; nx = cnt > 0u ? cnt : 1u;
}
__device__ __forceinline__ void xcd_barrier(const XcdBarrier& b) {
    asm volatile("s_waitcnt vmcnt(0)" ::: "memory");
    __syncthreads();
    if (threadIdx.x == 0) {
        unsigned* bar = b.bar;
        __builtin_amdgcn_s_waitcnt(0);
        unsigned nloc = b.st[0], nx = b.st[1];
        if (nloc == 0u) { xcd_barrier_complete(bar, b.x, nloc, nx); b.st[0] = nloc; b.st[1] = nx; }
        const unsigned old = xb_add(&bar[XB_XSUB(b.x)], 1u);
        const unsigned gen = old / nloc;
        if (old + 1u == (gen + 1u) * nloc) {
            __builtin_amdgcn_fence(__ATOMIC_RELEASE, "agent");
            asm volatile("s_waitcnt vmcnt(0)" ::: "memory");
            const unsigned og = xb_add(&bar[XB_TOP], 1u);
            const unsigned tg = og / nx;
            if (og + 1u == (tg + 1u) * nx) xb_add(&bar[XB_TOPGEN], 1u);
            else XB_SPIN(xb_ld(&bar[XB_TOPGEN]) == tg, bar);
            __builtin_amdgcn_fence(__ATOMIC_ACQUIRE, "agent");
            xb_add(&bar[XB_XGEN(b.x)], 1u);
            asm volatile("s_waitcnt vmcnt(0)" ::: "memory");
        } else {
            XB_SPIN(xb_ld(&bar[XB_XGEN(b.x)]) == gen, bar);
            __builtin_amdgcn_fence(__ATOMIC_ACQUIRE, "agent");
            asm volatile("s_waitcnt vmcnt(0)" ::: "memory");
        }
    }
    __syncthreads();
}

namespace pg8 {
constexpr int BM = 256, BK = 64, HALF = 128, HTB = HALF * BK * 2, STAGE_BYTES = 8 * HTB, NXCD = 8, WGM = 8;
__device__ __forceinline__ int lds_byte(int r, int c) { const int st = (r >> 4) * 2 + (c >> 5), rr = r & 15, cc = c & 31, ob = rr * 64 + cc * 2; return st * 1024 + (ob ^ (((ob >> 9) & 1) << 5)); }
__device__ __forceinline__ void stage_rc(int b, int& R, int& C) { const int st = b / 1024, sb = b % 1024, swz = sb ^ (((sb >> 9) & 1) << 5); R = (st >> 1) * 16 + swz / 64; C = (st & 1) * 32 + (swz % 64) / 2; }
__device__ __forceinline__ int perm32(int rho) { const int n = rho >> 4, i = rho & 15; return 8 * (i >> 2) + 4 * n + (i & 3); }

struct Unit { int pm, pn, z; };
struct Order {
    int nM, nN, nZ2, per, nwg, G, c;
    const char* A; const char* Bt; size_t tA, tB, zA1, zA2, zB1, zB2, pmB;
    __device__ __forceinline__ void init(const void* A_, int lda, const void* Bt_, int ldb, int nM_, int nN_, int nZ1, int nZ2_,
                                         size_t zA1_, size_t zA2_, size_t zB1_, size_t zB2_, int G_, int c_) {
        A = (const char*)A_; Bt = (const char*)Bt_; nM = nM_; nN = nN_; nZ2 = nZ2_; per = nM_ * nN_; nwg = per * nZ1 * nZ2_; G = G_; c = c_;
        tA = (size_t)BM * lda * 2; tB = (size_t)BM * ldb * 2; zA1 = zA1_; zA2 = zA2_; zB1 = zB1_; zB2 = zB2_; pmB = 0;
    }
    __device__ __forceinline__ bool next(int i, Unit& u) const {
        const long L = (long)i * G + c; if (c < 0 || L >= nwg) return false;
        int wgid = (int)L; { const int q = nwg / NXCD, r = nwg % NXCD, xcd = wgid % NXCD, off = wgid / NXCD; wgid = (xcd < r ? xcd * (q + 1) : r * (q + 1) + (xcd - r) * q) + off; }
        u.z = wgid / per; const int w = wgid - u.z * per;
        const int nig = WGM * nN, gid = w / nig, fm = gid * WGM, gsz = (nM - fm) < WGM ? (nM - fm) : WGM;
        u.pm = fm + ((w % nig) % gsz); u.pn = (w % nig) / gsz; return true;
    }
    __device__ __forceinline__ const char* aptr(const Unit& u) const { return A + (size_t)(u.z / nZ2) * zA1 + (size_t)(u.z % nZ2) * zA2 + (size_t)u.pm * tA; }
    __device__ __forceinline__ const char* bptr(const Unit& u) const { return Bt + (size_t)(u.z / nZ2) * zB1 + (size_t)(u.z % nZ2) * zB2 + (size_t)u.pn * tB + (size_t)u.pm * pmB; }
};

template <int MODE = 0, class Epi>
__device__ __forceinline__ void gemm_phase(LAS unsigned char* lds, const int K, const int lda, const int ldb, const Order& S, const Epi& E) {
    constexpr bool F8 = (MODE == 1), I8 = (MODE == 2);
    const int tid = threadIdx.x, wid = __builtin_amdgcn_readfirstlane(tid >> 6), lane = tid & 63, wr = wid >> 2, wc = wid & 3, fr = lane & 15, fq = lane >> 4;
    const int nt = K / BK;
    unsigned voffA[2], voffB[2];
#pragma unroll
    for (int i = 0; i < 2; ++i) { int R, C; stage_rc(tid * 16 + i * 8192, R, C); const int Rb = Epi::PERM ? ((R & ~31) + perm32(R & 31)) : R;
        voffA[i] = (unsigned)(R * lda + C) * 2u; voffB[i] = (unsigned)(Rb * ldb + C) * 2u; }
    const size_t kstep = (size_t)(BK * 2);
    const size_t hstepA = (size_t)HALF * lda * 2, hstepB = (size_t)HALF * ldb * 2;
    const unsigned ldsw = (unsigned)wid * 1024u;
    const int f8in = (((fr * 64) + (fq & 1) * 32) ^ ((fr >> 3) << 5)) + (fq >> 1) * 1024;
    const int aoff = F8 ? wr * 8192 + f8in : lds_byte(wr * 64 + fr, fq * 8), boff = F8 ? wc * 4096 + f8in : lds_byte(wc * 32 + fr, fq * 8);
    constexpr int KCH = F8 ? 16 : 1024;
#define PG8_SA(b, h) (((b) * 2 + (h)) * HTB)
#define PG8_SB(b, h) ((4 + (b) * 2 + (h)) * HTB)
#define PG8_STAGE(bufoff, gbase, voff) do { _Pragma("unroll") for (int _i = 0; _i < 2; ++_i) \
        __builtin_amdgcn_global_load_lds((const unsigned*)((const char*)(gbase) + (voff)[_i]), (LAS unsigned*)(lds + (bufoff) + ldsw + _i * 8192), 16, 0, 0); } while (0)
#define PG8_LDA(dst, b, h) do { _Pragma("unroll") for (int m = 0; m < 4; ++m) _Pragma("unroll") for (int k = 0; k < 2; ++k) dst[m][k] = *(const LAS bf16x8*)(lds + PG8_SA(b, h) + aoff + m * 2048 + k * KCH); } while (0)
#define PG8_LDB(dst, b, h) do { _Pragma("unroll") for (int n = 0; n < 2; ++n) _Pragma("unroll") for (int k = 0; k < 2; ++k) dst[n][k] = *(const LAS bf16x8*)(lds + PG8_SB(b, h) + boff + n * 2048 + k * KCH); } while (0)
#define PG8_MMA(ai, bj, At, Bt) do { __builtin_amdgcn_s_setprio(1); _Pragma("unroll") for (int m = 0; m < 4; ++m) _Pragma("unroll") for (int n = 0; n < 2; ++n) { \
        if constexpr (F8) { typedef int v4i_ __attribute__((ext_vector_type(4))); typedef int v8i_ __attribute__((ext_vector_type(8))); \
            const v8i_ a8_ = __builtin_shufflevector(__builtin_bit_cast(v4i_, At[m][0]), __builtin_bit_cast(v4i_, At[m][1]), 0, 1, 2, 3, 4, 5, 6, 7); \
            const v8i_ b8_ = __builtin_shufflevector(__builtin_bit_cast(v4i_, Bt[n][0]), __builtin_bit_cast(v4i_, Bt[n][1]), 0, 1, 2, 3, 4, 5, 6, 7); \
            asm volatile("v_mfma_f32_16x16x128_f8f6f4 %0, %1, %2, %0" : "+v"(acc[ai][bj][m][n]) : "v"(b8_), "v"(a8_)); }   \
        else if constexpr (I8) { typedef int v4i_ __attribute__((ext_vector_type(4))); _Pragma("unroll") for (int k = 0; k < 2; ++k) \
            acc[ai][bj][m][n] = __builtin_bit_cast(f32x4, __builtin_amdgcn_mfma_i32_16x16x64_i8(__builtin_bit_cast(v4i_, Bt[n][k]), __builtin_bit_cast(v4i_, At[m][k]), __builtin_bit_cast(v4i_, acc[ai][bj][m][n]), 0, 0, 0)); } \
        else { _Pragma("unroll") for (int k = 0; k < 2; ++k) acc[ai][bj][m][n] = __builtin_amdgcn_mfma_f32_16x16x32_bf16(Bt[n][k], At[m][k], acc[ai][bj][m][n], 0, 0, 0); } } \
        __builtin_amdgcn_s_setprio(0); } while (0)
#define PG8_WAIT_V(n) asm volatile("s_waitcnt vmcnt(" #n ")" ::: "memory")
#define PG8_WAIT_L(n) asm volatile("s_waitcnt lgkmcnt(" #n ")" ::: "memory")
#define PG8_BAR __builtin_amdgcn_s_barrier()
#define PG8_SCHED __builtin_amdgcn_sched_barrier(0)
    Unit cur, nxt; int ui = 0;
    if (!S.next(0, cur)) return;
    f32x4 acc[2][2][4][2];
#pragma unroll
    for (int a = 0; a < 2; ++a)
#pragma unroll
        for (int b = 0; b < 2; ++b)
#pragma unroll
            for (int m = 0; m < 4; ++m)
#pragma unroll
                for (int n = 0; n < 2; ++n) acc[a][b][m][n] = (f32x4){0.f, 0.f, 0.f, 0.f};
    bf16x8 At[4][2], B0[2][2], B1[2][2];
    const char* cA = S.aptr(cur); const char* cB = S.bptr(cur);
    PG8_STAGE(PG8_SB(0, 0), cB, voffB); PG8_STAGE(PG8_SB(0, 1), cB + hstepB, voffB); PG8_STAGE(PG8_SA(0, 0), cA, voffA); PG8_STAGE(PG8_SA(0, 1), cA + hstepA, voffA);
    if (wr == 1) PG8_BAR;
    PG8_WAIT_V(2); PG8_BAR;
    PG8_STAGE(PG8_SB(1, 0), cB + kstep, voffB); PG8_STAGE(PG8_SA(1, 0), cA + kstep, voffA); PG8_STAGE(PG8_SB(1, 1), cB + hstepB + kstep, voffB);
    PG8_WAIT_V(6); PG8_BAR;
    for (;;) {
        const bool has_next = S.next(ui + 1, nxt);
        const char* nA = has_next ? S.aptr(nxt) : cA; const char* nB = has_next ? S.bptr(nxt) : cB;
#pragma unroll 1
        for (int t = 0; t < nt; t += 2) {
            const bool last = (t == nt - 2);
            const char* a1 = cA + (size_t)(t + 1) * kstep;
            const char* a2 = last ? nA : cA + (size_t)(t + 2) * kstep; const char* b2 = last ? nB : cB + (size_t)(t + 2) * kstep;
            const char* a3 = a2 + kstep; const char* b3 = b2 + kstep;
            PG8_LDB(B0, 0, 0); PG8_LDB(B1, 0, 1); PG8_SCHED; PG8_LDA(At, 0, 0); PG8_STAGE(PG8_SA(1, 1), a1 + hstepA, voffA);
            PG8_WAIT_V(8); PG8_WAIT_L(0); PG8_BAR; PG8_MMA(0, 0, At, B0); PG8_MMA(0, 1, At, B1); PG8_BAR; PG8_SCHED;
            PG8_LDA(At, 0, 1); PG8_STAGE(PG8_SB(0, 0), b2, voffB); PG8_STAGE(PG8_SB(0, 1), b2 + hstepB, voffB); PG8_STAGE(PG8_SA(0, 0), a2, voffA);
            PG8_WAIT_V(8); PG8_WAIT_L(0); PG8_BAR; PG8_MMA(1, 0, At, B0); PG8_MMA(1, 1, At, B1); PG8_BAR; PG8_SCHED;
            PG8_LDB(B0, 1, 0); PG8_LDB(B1, 1, 1); PG8_SCHED; PG8_LDA(At, 1, 0); PG8_STAGE(PG8_SA(0, 1), a2 + hstepA, voffA);
            PG8_WAIT_V(8); PG8_WAIT_L(0); PG8_BAR; PG8_MMA(0, 0, At, B0); PG8_MMA(0, 1, At, B1); PG8_BAR; PG8_SCHED;
            PG8_LDA(At, 1, 1); PG8_STAGE(PG8_SB(1, 0), b3, voffB); PG8_STAGE(PG8_SB(1, 1), b3 + hstepB, voffB); PG8_STAGE(PG8_SA(1, 0), a3, voffA);
            PG8_WAIT_V(8); PG8_WAIT_L(0); PG8_BAR; PG8_MMA(1, 0, At, B0); PG8_MMA(1, 1, At, B1); PG8_BAR; PG8_SCHED;
        }
        if constexpr (F8) { asm volatile("s_nop 15\n\ts_nop 15"); PG8_SCHED; }
        if constexpr (I8) { typedef int v4i_ __attribute__((ext_vector_type(4)));
#pragma unroll
            for (int a = 0; a < 2; ++a)
#pragma unroll
                for (int b = 0; b < 2; ++b)
#pragma unroll
                    for (int m = 0; m < 4; ++m)
#pragma unroll
                        for (int n = 0; n < 2; ++n) acc[a][b][m][n] = __builtin_convertvector(__builtin_bit_cast(v4i_, acc[a][b][m][n]), f32x4); }
        if (wr == 0) PG8_BAR;
        E(acc, cur, wr, wc, fr, fq);
        if (!has_next) break;
#pragma unroll
        for (int a = 0; a < 2; ++a)
#pragma unroll
            for (int b = 0; b < 2; ++b)
#pragma unroll
                for (int m = 0; m < 4; ++m)
#pragma unroll
                    for (int n = 0; n < 2; ++n) acc[a][b][m][n] = (f32x4){0.f, 0.f, 0.f, 0.f};
        cur = nxt; cA = nA; cB = nB; ++ui;
        if (wr == 1) PG8_BAR;
    }
    PG8_WAIT_V(0);
    PG8_BAR;
#undef PG8_SA
#undef PG8_SB
#undef PG8_STAGE
#undef PG8_LDA
#undef PG8_LDB
#undef PG8_MMA
#undef PG8_WAIT_V
#undef PG8_WAIT_L
#undef PG8_BAR
#undef PG8_SCHED
}

template <int ACT>
__device__ __forceinline__ void store_tile_bf16(const f32x4 (&acc)[2][2][4][2], bf16_t* p0, bf16_t* p1, int ld0, int ld1, int nv0, int nv1, float scale, int wr, int wc, int fr, int fq, const float* rs = nullptr  ) {
#pragma unroll
    for (int bj = 0; bj < 2; ++bj) {
        bf16_t* p = bj ? p1 : p0; const int ld = bj ? ld1 : ld0, nv = bj ? nv1 : nv0;
        if (p == nullptr || wc * 32 >= nv) continue;
#pragma unroll
        for (int ai = 0; ai < 2; ++ai)
#pragma unroll
            for (int m = 0; m < 4; ++m) {
                const int row = ai * HALF + wr * 64 + m * 16 + fr;
                const float sc_ = rs ? scale * rs[ai * 4 + m] : scale;
                f32x4 v0 = acc[ai][bj][m][0] * sc_, v1 = acc[ai][bj][m][1] * sc_;
                if (ACT == 1) {
#pragma unroll
                    for (int j = 0; j < 4; ++j) { const float a = fmaxf(v0[j], 0.f), b = fmaxf(v1[j], 0.f); v0[j] = a * a; v1[j] = b * b; } }
                u32x4 w; w.x = cvt_pk_bf16(v0[0], v0[1]); w.y = cvt_pk_bf16(v0[2], v0[3]); w.z = cvt_pk_bf16(v1[0], v1[1]); w.w = cvt_pk_bf16(v1[2], v1[3]);
                *(u32x4*)(p + (size_t)row * ld + wc * 32 + 8 * fq) = w;
            }
    }
}
struct EpiInProj {
    static constexpr bool PERM = true;
    bf16_t *zf, *cq, *ckv, *kr; const float* rstdx; float *ssq_q, *ssq_kv;
    __device__ __forceinline__ void operator()(const f32x4 (&acc)[2][2][4][2], const Unit& u, int wr, int wc, int fr, int fq) const {
        asm volatile("" : "+v"(fr), "+v"(fq));
        const size_t r0 = (size_t)u.pm * BM; bf16_t *p0, *p1; int ld, nv0 = 128, nv1 = 128;
        if (u.pn < 8)       { ld = FW;  p0 = zf + r0 * FW + u.pn * 256; p1 = p0 + 128; }
        else if (u.pn < 12) { ld = QR;  p0 = cq + r0 * QR + (u.pn - 8) * 256; p1 = p0 + 128; }
        else if (u.pn < 14) { ld = KVR; p0 = ckv + r0 * KVR + (u.pn - 12) * 256; p1 = p0 + 128; }
        else                { ld = DROPE; p0 = kr + r0 * DROPE; p1 = nullptr; nv0 = 64; nv1 = 0; }
        float rs[8];
#pragma unroll
        for (int ai = 0; ai < 2; ++ai)
#pragma unroll
            for (int m = 0; m < 4; ++m) rs[ai * 4 + m] = rstdx[r0 + ai * HALF + wr * 64 + m * 16 + fr];
        store_tile_bf16<0>(acc, p0, p1, ld, ld, nv0, nv1, 1.f, wr, wc, fr, fq, rs);
    }
};
template <int ACT>
struct EpiBf16Lin {
    static constexpr bool PERM = true;
    bf16_t* out; int ld, nZ2; size_t sz1, sz2, spm, spn; float scale;
    __device__ __forceinline__ void operator()(const f32x4 (&acc)[2][2][4][2], const Unit& u, int wr, int wc, int fr, int fq) const {
        asm volatile("" : "+v"(fr), "+v"(fq));
        bf16_t* p0 = out + (size_t)(u.z / nZ2) * sz1 + (size_t)(u.z % nZ2) * sz2 + (size_t)u.pm * spm + (size_t)u.pn * spn;
        store_tile_bf16<ACT>(acc, p0, p0 + 128, ld, ld, 128, 128, scale, wr, wc, fr, fq);
    }
};
struct EpiQ {
    static constexpr bool PERM = true;
    bf16_t* Q; const float* rc; const float* rs; const float* ssq;
    __device__ __forceinline__ void operator()(const f32x4 (&acc)[2][2][4][2], const Unit& u, int wr, int wc, int fr, int fq) const {
        asm volatile("" : "+v"(fr), "+v"(fq));
        const int colb = u.pn * 256 + wc * 32 + 8 * fq;
#pragma unroll
        for (int ai = 0; ai < 2; ++ai)
#pragma unroll
            for (int m = 0; m < 4; ++m) {
                const int row = u.pm * BM + ai * HALF + wr * 64 + m * 16 + fr; const float rq = 1.f;
#pragma unroll
                for (int bj = 0; bj < 2; ++bj) {
                    const int col = colb + bj * 128, w = col % DQK;
                    f32x4 v0 = acc[ai][bj][m][0] * rq, v1 = acc[ai][bj][m][1] * rq;
                    if (w >= DNOPE) {
                        const int p0 = (w - DNOPE) >> 1;
                        const f32x4 c = *(const f32x4*)(rc + (size_t)row * 32 + p0), s = *(const f32x4*)(rs + (size_t)row * 32 + p0);
                        const f32x4 a0 = v0, a1 = v1;
                        v0[0] = a0[0] * c[0] - a0[1] * s[0]; v0[1] = a0[0] * s[0] + a0[1] * c[0];
                        v0[2] = a0[2] * c[1] - a0[3] * s[1]; v0[3] = a0[2] * s[1] + a0[3] * c[1];
                        v1[0] = a1[0] * c[2] - a1[1] * s[2]; v1[1] = a1[0] * s[2] + a1[1] * c[2];
                        v1[2] = a1[2] * c[3] - a1[3] * s[3]; v1[3] = a1[2] * s[3] + a1[3] * c[3];
                    }
                    u32x4 o; o.x = cvt_pk_bf16(v0[0], v0[1]); o.y = cvt_pk_bf16(v0[2], v0[3]); o.z = cvt_pk_bf16(v1[0], v1[1]); o.w = cvt_pk_bf16(v1[2], v1[3]);
                    *(u32x4*)(Q + (size_t)row * (NH * DQK) + col) = o;
                }
                asm volatile("" ::: "memory");
            }
    }
};
struct EpiKV8 {
    static constexpr bool PERM = true;
    signed char* K8p; float* k8sp; bf16_t* Vb; const unsigned* krr; const float* krmax; LAS float* tab;
    __device__ __forceinline__ void operator()(const f32x4 (&acc)[2][2][4][2], const Unit& u, int wr, int wc, int fr, int fq) const {
        asm volatile("" : "+v"(fr), "+v"(fq));
        const size_t r0 = (size_t)u.pm * BM; const int h = u.pn; float bm[2][2];
#pragma unroll
        for (int ai = 0; ai < 2; ++ai)
#pragma unroll
            for (int mp = 0; mp < 2; ++mp) { float mx = 0.f;
#pragma unroll
                for (int mm = 0; mm < 2; ++mm) { const int m = 2 * mp + mm; mx = fmaxf(mx, krmax[r0 + ai * HALF + wr * 64 + m * 16 + fr]);
#pragma unroll
                    for (int n = 0; n < 2; ++n) { const f32x4 v = acc[ai][0][m][n]; mx = fmaxf(mx, fmaxf(fmaxf(fabsf(v[0]), fabsf(v[1])), fmaxf(fabsf(v[2]), fabsf(v[3])))); } }
#pragma unroll
                for (int o = 32; o > 0; o >>= 1) mx = fmaxf(mx, __shfl_xor(mx, o));
                if (fr == 0 && fq == 0) tab[((wr * 2 + ai) * 2 + mp) * 4 + wc] = mx; }
        asm volatile("s_waitcnt lgkmcnt(0)" ::: "memory"); __builtin_amdgcn_s_barrier(); asm volatile("" ::: "memory");
#pragma unroll
        for (int ai = 0; ai < 2; ++ai)
#pragma unroll
            for (int mp = 0; mp < 2; ++mp) { const f32x4 t4 = *(LAS const f32x4*)(tab + ((wr * 2 + ai) * 2 + mp) * 4); bm[ai][mp] = fmaxf(fmaxf(t4[0], t4[1]), fmaxf(t4[2], t4[3])); }
#pragma unroll
        for (int ai = 0; ai < 2; ++ai)
#pragma unroll
            for (int m = 0; m < 4; ++m) { const size_t t = r0 + ai * HALF + wr * 64 + m * 16 + fr; const int b = (int)(t / SEQ), sp = (int)(t % SEQ); const float mx = bm[ai][m >> 1], isc = mx > 0.f ? 127.f / mx : 0.f;
                signed char* kr = K8p + ((size_t)(b * NH + h) * SEQ + sp) * DQK;
                if (wc == 0 && fq == 0 && (m & 1) == 0 && fr == 0) k8sp[((size_t)(b * NH + h) * SEQ + sp) >> 5] = mx * (1.f / 127.f);
                const f32x4 v0 = acc[ai][0][m][0] * isc, v1 = acc[ai][0][m][1] * isc; u32x2 o;
                o.x = (unsigned)(((int)__builtin_rintf(v0[0]) & 0xff) | (((int)__builtin_rintf(v0[1]) & 0xff) << 8) | (((int)__builtin_rintf(v0[2]) & 0xff) << 16) | ((int)__builtin_rintf(v0[3]) << 24));
                o.y = (unsigned)(((int)__builtin_rintf(v1[0]) & 0xff) | (((int)__builtin_rintf(v1[1]) & 0xff) << 8) | (((int)__builtin_rintf(v1[2]) & 0xff) << 16) | ((int)__builtin_rintf(v1[3]) << 24));
                *(u32x2*)(kr + wc * 32 + 8 * fq) = o;
                const u32x2 rw = *(const u32x2*)(krr + t * 32 + wc * 8 + fq * 2);
                const unsigned q = (unsigned)(((int)__builtin_rintf(bflo(rw.x) * isc) & 0xff) | (((int)__builtin_rintf(bfhi(rw.x) * isc) & 0xff) << 8) | (((int)__builtin_rintf(bflo(rw.y) * isc) & 0xff) << 16) | ((int)__builtin_rintf(bfhi(rw.y) * isc) << 24));
                *(unsigned*)(kr + DNOPE + wc * 16 + fq * 4) = q; }
        store_tile_bf16<0>(acc, nullptr, Vb + r0 * (NH * DV) + u.pn * DV, NH * DQK, NH * DV, 128, 128, 1.f, wr, wc, fr, fq);
    }
};
struct EpiKV {
    static constexpr bool PERM = true;
    bf16_t *Kb, *Vb; const float* ssq;
    __device__ __forceinline__ void operator()(const f32x4 (&acc)[2][2][4][2], const Unit& u, int wr, int wc, int fr, int fq) const {
        asm volatile("" : "+v"(fr), "+v"(fq));
        const size_t r0 = (size_t)u.pm * BM; float rs[8];
#pragma unroll
        for (int ai = 0; ai < 2; ++ai)
#pragma unroll
            for (int m = 0; m < 4; ++m) rs[ai * 4 + m] = 1.f;
        store_tile_bf16<0>(acc, Kb + r0 * (NH * DQK) + u.pn * DQK, Vb + r0 * (NH * DV) + u.pn * DV, NH * DQK, NH * DV, 128, 128, 1.f, wr, wc, fr, fq, rs);
    }
};

struct EpiBf16ColGain {
    static constexpr bool PERM = true;
    bf16_t* out; const float* cg; int ld, nZ2; size_t sz1, sz2, spm, spn;
    __device__ __forceinline__ void operator()(const f32x4 (&acc)[2][2][4][2], const Unit& u, int wr, int wc, int fr, int fq) const {
        asm volatile("" : "+v"(fr), "+v"(fq));
        bf16_t* p0 = out + (size_t)(u.z / nZ2) * sz1 + (size_t)(u.z % nZ2) * sz2 + (size_t)u.pm * spm + (size_t)u.pn * spn;
#pragma unroll
        for (int bj = 0; bj < 2; ++bj) { const int colt = bj * 128 + wc * 32 + 8 * fq; const f32x4 g0 = *(const f32x4*)(cg + u.pn * 256 + colt), g1 = *(const f32x4*)(cg + u.pn * 256 + colt + 4);
#pragma unroll
            for (int ai = 0; ai < 2; ++ai)
#pragma unroll
                for (int m = 0; m < 4; ++m) { const int row = ai * HALF + wr * 64 + m * 16 + fr; const f32x4 v0 = acc[ai][bj][m][0] * g0, v1 = acc[ai][bj][m][1] * g1;
                    u32x4 w; w.x = cvt_pk_bf16(v0[0], v0[1]); w.y = cvt_pk_bf16(v0[2], v0[3]); w.z = cvt_pk_bf16(v1[0], v1[1]); w.w = cvt_pk_bf16(v1[2], v1[3]);
                    *(u32x4*)(p0 + (size_t)row * ld + colt) = w; } }
    }
};
struct EpiFFN1 {
    static constexpr bool PERM = true;
    bf16_t* out; const float* rsc; const float* csc; unsigned* amax; int ld;
    __device__ __forceinline__ void operator()(const f32x4 (&acc)[2][2][4][2], const Unit& u, int wr, int wc, int fr, int fq) const {
        asm volatile("" : "+v"(fr), "+v"(fq));
        bf16_t* p0 = out + (size_t)u.pm * BM * ld + (size_t)u.pn * 256 + wc * 32 + 8 * fq;
        f32x4 cs[2][2];
#pragma unroll
        for (int bj = 0; bj < 2; ++bj) { const float* cp = csc + u.pn * 256 + bj * 128 + wc * 32 + 8 * fq; cs[bj][0] = *(const f32x4*)cp * (1.f / 127.f); cs[bj][1] = *(const f32x4*)(cp + 4) * (1.f / 127.f); }
#pragma unroll
        for (int ai = 0; ai < 2; ++ai)
#pragma unroll
            for (int m = 0; m < 4; ++m) { const int row = ai * HALF + wr * 64 + m * 16 + fr; const float r = rsc[u.pm * BM + row]; float mx = 0.f;
#pragma unroll
                for (int bj = 0; bj < 2; ++bj) { f32x4 v0 = acc[ai][bj][m][0] * cs[bj][0] * r, v1 = acc[ai][bj][m][1] * cs[bj][1] * r;
#pragma unroll
                    for (int j = 0; j < 4; ++j) { const float a = fmaxf(v0[j], 0.f), b = fmaxf(v1[j], 0.f); v0[j] = a * a; v1[j] = b * b; mx = fmaxf(mx, fmaxf(v0[j], v1[j])); }
                    u32x4 w; w.x = cvt_pk_bf16(v0[0], v0[1]); w.y = cvt_pk_bf16(v0[2], v0[3]); w.z = cvt_pk_bf16(v1[0], v1[1]); w.w = cvt_pk_bf16(v1[2], v1[3]);
                    *(u32x4*)(p0 + (size_t)row * ld + bj * 128) = w; }
                (void)mx; }
    }
};

template <bool RF32, bool SSQ>
struct EpiResB {
    static constexpr bool PERM = true;
    const void* R; bf16_t* Hb; float* ssq; int ldc; int rows_per_z; unsigned char* H8; unsigned* rmax; const float* rsc; const float* csc; const int* coff; float ascale;
    __device__ __forceinline__ void operator()(const f32x4 (&acc)[2][2][4][2], const Unit& u, int wr, int wc, int fr, int fq) const {
        asm volatile("" : "+v"(fr), "+v"(fq));
        const size_t row0 = (size_t)u.z * rows_per_z + (size_t)u.pm * BM + wr * 64 + fr; const int colb = u.pn * BM + wc * 32 + 8 * fq;
        f32x4 cs[2][2], of[2][2];
#pragma unroll
        for (int bj = 0; bj < 2; ++bj) { if (coff) { const int* op = coff + colb + bj * HALF;
#pragma unroll
                for (int e = 0; e < 4; ++e) { of[bj][0][e] = 128.f * (float)op[e]; of[bj][1][e] = 128.f * (float)op[4 + e]; } } else { of[bj][0] = (f32x4){0.f, 0.f, 0.f, 0.f}; of[bj][1] = of[bj][0]; }
            if (csc) { cs[bj][0] = *(const f32x4*)(csc + colb + bj * HALF) * (ascale / 127.f); cs[bj][1] = *(const f32x4*)(csc + colb + bj * HALF + 4) * (ascale / 127.f); }
            else { cs[bj][0] = (f32x4){ascale, ascale, ascale, ascale}; cs[bj][1] = cs[bj][0]; } }
#pragma unroll
        for (int ai = 0; ai < 2; ++ai)
#pragma unroll
            for (int m = 0; m < 4; ++m) { const size_t row = row0 + ai * HALF + m * 16; float s = 0.f, mx = 0.f; const float rf = rsc ? rsc[row] : 1.f;
#pragma unroll
                for (int bj = 0; bj < 2; ++bj) { const size_t off = row * ldc + colb + bj * HALF; f32x4 r0, r1;
                    if (RF32) { r0 = __builtin_nontemporal_load((const f32x4*)((const float*)R + off)); r1 = __builtin_nontemporal_load((const f32x4*)((const float*)R + off + 4)); }
                    else { const u32x4 w = *(const u32x4*)((const bf16_t*)R + off); r0 = (f32x4){bflo(w.x), bfhi(w.x), bflo(w.y), bfhi(w.y)}; r1 = (f32x4){bflo(w.z), bfhi(w.z), bflo(w.w), bfhi(w.w)}; }
                    const f32x4 o0 = (acc[ai][bj][m][0] + of[bj][0]) * (cs[bj][0] * rf) + r0, o1 = (acc[ai][bj][m][1] + of[bj][1]) * (cs[bj][1] * rf) + r1;
                    u32x4 w; w.x = cvt_pk_bf16(o0[0], o0[1]); w.y = cvt_pk_bf16(o0[2], o0[3]); w.z = cvt_pk_bf16(o1[0], o1[1]); w.w = cvt_pk_bf16(o1[2], o1[3]);
                    *(u32x4*)(Hb + off) = w;
                    if (H8) *(u32x2*)(H8 + off) = cvt_pk8_fp8(o0, o1);
                    if (rmax) mx = fmaxf(mx, fmaxf(fmaxf(fmaxf(fabsf(o0[0]), fabsf(o0[1])), fmaxf(fabsf(o0[2]), fabsf(o0[3]))), fmaxf(fmaxf(fabsf(o1[0]), fabsf(o1[1])), fmaxf(fabsf(o1[2]), fabsf(o1[3])))));
                    if (SSQ) s += ((o0[0] * o0[0] + o0[1] * o0[1]) + (o0[2] * o0[2] + o0[3] * o0[3])) + ((o1[0] * o1[0] + o1[1] * o1[1]) + (o1[2] * o1[2] + o1[3] * o1[3])); }
                if (SSQ) { s += __shfl_xor(s, 16); s += __shfl_xor(s, 32); if (fq == 0) atomicAdd(ssq + row, s); }
                if (rmax) { mx = fmaxf(mx, __shfl_xor(mx, 16)); mx = fmaxf(mx, __shfl_xor(mx, 32)); if (fq == 0) atomicMax(rmax + row, __float_as_uint(mx)); }
                asm volatile("" ::: "memory"); }
    }
};

struct EpiSoftmax {
    static constexpr bool PERM = true;
    unsigned char* P; const float* rss; int ldp; float scale; int rows_per_z; LAS float* tab;
    __device__ __forceinline__ void operator()(f32x4 (&acc)[2][2][4][2], const Unit& u, int wr, int wc, int fr, int fq) const {
        asm volatile("" : "+v"(fr), "+v"(fq));
        const size_t row0 = (size_t)u.z * rows_per_z + (size_t)u.pm * BM; const int rl0 = wr * 64 + fr;
        LAS float* tmax = tab; LAS float* tsum = tab + 1024;
#pragma unroll
        for (int ai = 0; ai < 2; ++ai)
#pragma unroll
            for (int m = 0; m < 4; ++m) { const int rl = rl0 + ai * HALF + m * 16; const float sc = scale * 1.4426950408889634f * rsqrtf(rss[row0 + rl] * (1.f / DM) + NORM_EPS); float mx = -3.0e38f;
#pragma unroll
                for (int bj = 0; bj < 2; ++bj)
#pragma unroll
                    for (int n = 0; n < 2; ++n) { acc[ai][bj][m][n] = acc[ai][bj][m][n] * sc; const f32x4 v = acc[ai][bj][m][n]; mx = fmaxf(mx, fmaxf(fmaxf(v[0], v[1]), fmaxf(v[2], v[3]))); }
                mx = fmaxf(mx, __shfl_xor(mx, 16)); mx = fmaxf(mx, __shfl_xor(mx, 32));
                if (fq == 0) tmax[rl * 4 + wc] = mx; }
        asm volatile("s_waitcnt lgkmcnt(0)" ::: "memory"); __builtin_amdgcn_s_barrier(); asm volatile("" ::: "memory");
#pragma unroll
        for (int ai = 0; ai < 2; ++ai)
#pragma unroll
            for (int m = 0; m < 4; ++m) { const int rl = rl0 + ai * HALF + m * 16; const f32x4 t = *(LAS const f32x4*)(tmax + rl * 4); const float mx = fmaxf(fmaxf(t[0], t[1]), fmaxf(t[2], t[3])); float sm = 0.f;
#pragma unroll
                for (int bj = 0; bj < 2; ++bj)
#pragma unroll
                    for (int n = 0; n < 2; ++n) { f32x4 v = acc[ai][bj][m][n];
#pragma unroll
                        for (int j = 0; j < 4; ++j) v[j] = __builtin_amdgcn_exp2f(v[j] - mx);
                        acc[ai][bj][m][n] = v; sm += (v[0] + v[1]) + (v[2] + v[3]); }
                sm += __shfl_xor(sm, 16); sm += __shfl_xor(sm, 32);
                if (fq == 0) tsum[rl * 4 + wc] = sm; }
        asm volatile("s_waitcnt lgkmcnt(0)" ::: "memory"); __builtin_amdgcn_s_barrier(); asm volatile("" ::: "memory");
#pragma unroll
        for (int ai = 0; ai < 2; ++ai)
#pragma unroll
            for (int m = 0; m < 4; ++m) { const int rl = rl0 + ai * HALF + m * 16; const f32x4 t = *(LAS const f32x4*)(tsum + rl * 4); const float inv = __builtin_amdgcn_rcpf((t[0] + t[1]) + (t[2] + t[3]));
#pragma unroll
                for (int bj = 0; bj < 2; ++bj) { const f32x4 v0 = acc[ai][bj][m][0] * (inv * 256.f), v1 = acc[ai][bj][m][1] * (inv * 256.f);
                    *(u32x2*)(P + (row0 + rl) * ldp + u.pn * BM + bj * HALF + wc * 32 + 8 * fq) = cvt_pk8_fp8(v0, v1); } }
    }
};

struct EpiF8ColGain {
    static constexpr bool PERM = true;
    unsigned char* out; const float* cg; int ld, nZ2; size_t sz1, sz2, spm, spn;
    __device__ __forceinline__ void operator()(const f32x4 (&acc)[2][2][4][2], const Unit& u, int wr, int wc, int fr, int fq) const {
        asm volatile("" : "+v"(fr), "+v"(fq));
        unsigned char* p0 = out + (size_t)(u.z / nZ2) * sz1 + (size_t)(u.z % nZ2) * sz2 + (size_t)u.pm * spm + (size_t)u.pn * spn;
#pragma unroll
        for (int bj = 0; bj < 2; ++bj) { const int colt = bj * 128 + wc * 32 + 8 * fq; const f32x4 g0 = *(const f32x4*)(cg + u.pn * 256 + colt), g1 = *(const f32x4*)(cg + u.pn * 256 + colt + 4);
#pragma unroll
            for (int ai = 0; ai < 2; ++ai)
#pragma unroll
                for (int m = 0; m < 4; ++m) { const int row = ai * HALF + wr * 64 + m * 16 + fr;
                    *(u32x2*)(p0 + (size_t)row * ld + colt) = cvt_pk8_fp8(acc[ai][bj][m][0] * g0, acc[ai][bj][m][1] * g1); } }
    }
};
struct EpiF8Lin {
    static constexpr bool PERM = true;
    unsigned char* out; int ld, nZ2; size_t sz1, sz2, spm, spn;
    __device__ __forceinline__ void operator()(const f32x4 (&acc)[2][2][4][2], const Unit& u, int wr, int wc, int fr, int fq) const {
        asm volatile("" : "+v"(fr), "+v"(fq));
        unsigned char* p0 = out + (size_t)(u.z / nZ2) * sz1 + (size_t)(u.z % nZ2) * sz2 + (size_t)u.pm * spm + (size_t)u.pn * spn;
#pragma unroll
        for (int bj = 0; bj < 2; ++bj) { const int colt = bj * 128 + wc * 32 + 8 * fq;
#pragma unroll
            for (int ai = 0; ai < 2; ++ai)
#pragma unroll
                for (int m = 0; m < 4; ++m) { const int row = ai * HALF + wr * 64 + m * 16 + fr;
                    *(u32x2*)(p0 + (size_t)row * ld + colt) = cvt_pk8_fp8(acc[ai][bj][m][0], acc[ai][bj][m][1]); } }
    }
};
}

namespace att {
constexpr int QBLK = 32, KVBLK = 64;
constexpr int LDQ = NH * DQK, LDK = NH * DQK, LDV = NH * DV, LDO = FW;
constexpr int KROW = 400;
constexpr int SHM_V = KVBLK * DV * 2, SHM_K = KVBLK * KROW, SHM_ATTN = 2 * SHM_V + 2 * SHM_K + NWAVES * 64 * 4;
static_assert(SHM_ATTN <= RING_BYTES, "attention LDS");
constexpr float THR = 11.54f;
#define SBAR() __builtin_amdgcn_sched_barrier(0)
__device__ __forceinline__ int crow(int r, int hi) { return (r & 3) + 8 * (r >> 2) + 4 * hi; }
__device__ __forceinline__ void partialSM(f32x16& p0, f32x16& p1, float& m_reg, float& mn, float& alpha) {
  float pmax = p0[0];
#pragma unroll
  for (int r = 1; r < 16; ++r) pmax = fmaxf(pmax, p0[r]);
#pragma unroll
  for (int r = 0; r < 16; ++r) pmax = fmaxf(pmax, p1[r]);
  { auto rr = __builtin_amdgcn_permlane32_swap(__float_as_uint(pmax), __float_as_uint(pmax), false, false);
    pmax = fmaxf(__uint_as_float(rr[0]), __uint_as_float(rr[1])); }
  if (__builtin_expect(__all(pmax - m_reg <= THR), 1)) { mn = m_reg; alpha = 1.f; }
  else { mn = fmaxf(m_reg, pmax); alpha = __builtin_amdgcn_exp2f(m_reg - mn); m_reg = mn; }
#pragma unroll
  for (int r = 0; r < 16; ++r) p0[r] = p0[r] - mn;
#pragma unroll
  for (int r = 0; r < 16; ++r) p1[r] = p1[r] - mn;
#pragma unroll
  for (int r = 0; r < 16; ++r) p0[r] = __builtin_amdgcn_exp2f(p0[r]);
}
__device__ __forceinline__ void finishSM(f32x16& p0, f32x16& p1, float alpha, float& l_reg, bf16x8& pa0, bf16x8& pa1, bf16x8& pa2, bf16x8& pa3) {
#pragma unroll
  for (int r = 0; r < 16; ++r) p1[r] = __builtin_amdgcn_exp2f(p1[r]);
  float ps = 0;
#pragma unroll
  for (int r = 0; r < 16; ++r) ps += p0[r];
#pragma unroll
  for (int r = 0; r < 16; ++r) ps += p1[r];
  { auto rr = __builtin_amdgcn_permlane32_swap(__float_as_uint(ps), __float_as_uint(ps), false, false);
    ps = __uint_as_float(rr[0]) + __uint_as_float(rr[1]); }
  l_reg = l_reg * alpha + ps;
#define PK4(P, BASE, OUT) do { unsigned a0 = cvt_pk_bf16(P[BASE + 0], P[BASE + 1]), a1 = cvt_pk_bf16(P[BASE + 2], P[BASE + 3]);   \
    unsigned b0 = cvt_pk_bf16(P[BASE + 4], P[BASE + 5]), b1 = cvt_pk_bf16(P[BASE + 6], P[BASE + 7]);                              \
    auto r0 = __builtin_amdgcn_permlane32_swap(a0, b0, false, false); auto r1 = __builtin_amdgcn_permlane32_swap(a1, b1, false, false); \
    u32x4 w = {r0[0], r1[0], r0[1], r1[1]}; OUT = *reinterpret_cast<bf16x8*>(&w); } while (0)
  PK4(p0, 0, pa0); PK4(p0, 8, pa1); PK4(p1, 0, pa2); PK4(p1, 8, pa3);
#undef PK4
}
__device__ __forceinline__ void qkt(f32x16& p0, f32x16& p1, const char* Ks, const bf16x8 (&qr)[12], int r32, int hi) {
  p0 = f32x16{}; p1 = f32x16{};
#pragma unroll
  for (int d0 = 0; d0 < 12; ++d0) { const int cb = (d0 * 16 + hi * 8) * 2;
    bf16x8 b0 = *reinterpret_cast<const bf16x8*>(Ks + r32 * KROW + cb);
    bf16x8 b1 = *reinterpret_cast<const bf16x8*>(Ks + (32 + r32) * KROW + cb);
    p0 = __builtin_amdgcn_mfma_f32_32x32x16_bf16(b0, qr[d0], p0, 0, 0, 0);
    p1 = __builtin_amdgcn_mfma_f32_32x32x16_bf16(b1, qr[d0], p1, 0, 0, 0); }
}
__device__ __forceinline__ int v_st(int k, int c) { const int kk = (k & ~0xC) | ((k & 4) << 1) | ((k & 8) >> 1); return ((kk >> 3) * 4 + (c >> 5)) * 512 + ((kk & 7) * 32 + (c & 31)) * 2; }
__device__ __forceinline__ int v_rd_base(int lane) { return ((lane & 3) << 3) | (((lane >> 2) & 3) << 6) | (((lane >> 4) & 1) << 5) | (((lane >> 5) & 1) << 8); }
constexpr int v_rd_off(int d0, int ks, int half) { return d0 * 512 + ks * 4096 + half * 2048; }
template <int OFF> __device__ __forceinline__ s16x4 tr_read(int vb) {
  s16x4 r; asm volatile("ds_read_b64_tr_b16 %0, %1 offset:%2" : "=&v"(r) : "v"(vb), "i"(OFF) : "memory"); return r;
}
template <int D0> __device__ __forceinline__ void pv_one(f32x16& od, int vb, bf16x8 pa0, bf16x8 pa1, bf16x8 pa2, bf16x8 pa3) {
  const s16x4 l0 = tr_read<v_rd_off(D0, 0, 0)>(vb), h0 = tr_read<v_rd_off(D0, 0, 1)>(vb), l1 = tr_read<v_rd_off(D0, 1, 0)>(vb), h1 = tr_read<v_rd_off(D0, 1, 1)>(vb);
  const s16x4 l2 = tr_read<v_rd_off(D0, 2, 0)>(vb), h2 = tr_read<v_rd_off(D0, 2, 1)>(vb), l3 = tr_read<v_rd_off(D0, 3, 0)>(vb), h3 = tr_read<v_rd_off(D0, 3, 1)>(vb);
  asm volatile("s_waitcnt lgkmcnt(0)" ::: "memory"); SBAR();
#define PK(L, H) (bf16x8){L[0], L[1], L[2], L[3], H[0], H[1], H[2], H[3]}
  od = __builtin_amdgcn_mfma_f32_32x32x16_bf16(pa0, PK(l0, h0), od, 0, 0, 0);
  od = __builtin_amdgcn_mfma_f32_32x32x16_bf16(pa1, PK(l1, h1), od, 0, 0, 0);
  od = __builtin_amdgcn_mfma_f32_32x32x16_bf16(pa2, PK(l2, h2), od, 0, 0, 0);
  od = __builtin_amdgcn_mfma_f32_32x32x16_bf16(pa3, PK(l3, h3), od, 0, 0, 0);
#undef PK
}
__device__ __forceinline__ void pv_d0(f32x16* o, int vb, bf16x8 pa0, bf16x8 pa1, bf16x8 pa2, bf16x8 pa3) {
  pv_one<0>(o[0], vb, pa0, pa1, pa2, pa3); pv_one<1>(o[1], vb, pa0, pa1, pa2, pa3); pv_one<2>(o[2], vb, pa0, pa1, pa2, pa3); pv_one<3>(o[3], vb, pa0, pa1, pa2, pa3);
}
template <int D0> __device__ __forceinline__ void pv_rd(s16x4 (&f)[8], int vb) {
  f[0] = tr_read<v_rd_off(D0, 0, 0)>(vb); f[1] = tr_read<v_rd_off(D0, 0, 1)>(vb); f[2] = tr_read<v_rd_off(D0, 1, 0)>(vb); f[3] = tr_read<v_rd_off(D0, 1, 1)>(vb);
  f[4] = tr_read<v_rd_off(D0, 2, 0)>(vb); f[5] = tr_read<v_rd_off(D0, 2, 1)>(vb); f[6] = tr_read<v_rd_off(D0, 3, 0)>(vb); f[7] = tr_read<v_rd_off(D0, 3, 1)>(vb);
}
__device__ __forceinline__ void pv_mm(f32x16& od, const s16x4 (&f)[8], bf16x8 pa0, bf16x8 pa1, bf16x8 pa2, bf16x8 pa3) {
#define PK(L, H) (bf16x8){L[0], L[1], L[2], L[3], H[0], H[1], H[2], H[3]}
  od = __builtin_amdgcn_mfma_f32_32x32x16_bf16(pa0, PK(f[0], f[1]), od, 0, 0, 0);
  od = __builtin_amdgcn_mfma_f32_32x32x16_bf16(pa1, PK(f[2], f[3]), od, 0, 0, 0);
  od = __builtin_amdgcn_mfma_f32_32x32x16_bf16(pa2, PK(f[4], f[5]), od, 0, 0, 0);
  od = __builtin_amdgcn_mfma_f32_32x32x16_bf16(pa3, PK(f[6], f[7]), od, 0, 0, 0);
#undef PK
}
__device__ __forceinline__ void pv_d0p(f32x16* o, int vb, bf16x8 pa0, bf16x8 pa1, bf16x8 pa2, bf16x8 pa3) {
  s16x4 fa[8], fb[8];
  pv_rd<0>(fa, vb); pv_rd<1>(fb, vb);
  asm volatile("s_waitcnt lgkmcnt(8)" ::: "memory"); SBAR(); pv_mm(o[0], fa, pa0, pa1, pa2, pa3); SBAR();
  pv_rd<2>(fa, vb);
  asm volatile("s_waitcnt lgkmcnt(8)" ::: "memory"); SBAR(); pv_mm(o[1], fb, pa0, pa1, pa2, pa3); SBAR();
  pv_rd<3>(fb, vb);
  asm volatile("s_waitcnt lgkmcnt(8)" ::: "memory"); SBAR(); pv_mm(o[2], fa, pa0, pa1, pa2, pa3); SBAR();
  asm volatile("s_waitcnt lgkmcnt(0)" ::: "memory"); SBAR(); pv_mm(o[3], fb, pa0, pa1, pa2, pa3);
}
}


namespace att2 {
using namespace att;
constexpr int KSLOT = KVBLK * DQK * 2, VSLOT = KVBLK * DV * 2, K_OFF = 0, V_OFF = 3 * KSLOT, WS_OFF = V_OFF + 3 * VSLOT, SHM2 = WS_OFF + NWAVES * 64 * 4;
static_assert(SHM2 <= RING_BYTES, "attention v2 LDS");
__device__ __forceinline__ void qkt2(f32x16& p0, f32x16& p1, LAS const unsigned char* ks, const int (&kx)[4], const bf16x8 (&qr)[12]) {
  p0 = f32x16{}; p1 = f32x16{};
#pragma unroll
  for (int d0 = 0; d0 < 12; ++d0) {
    const bf16x8 b0 = *(LAS const bf16x8*)(ks + kx[d0 & 3] + (d0 >> 2) * 1024);
    const bf16x8 b1 = *(LAS const bf16x8*)(ks + kx[d0 & 3] + (d0 >> 2) * 1024 + 12288);
    p0 = __builtin_amdgcn_mfma_f32_32x32x16_bf16(b0, qr[d0], p0, 0, 0, 0);
    p1 = __builtin_amdgcn_mfma_f32_32x32x16_bf16(b1, qr[d0], p1, 0, 0, 0); }
}
}


namespace att4 {
using namespace att;
using namespace att2;
template <int ORDER>
__device__ __forceinline__ void attn_unit4(const bf16_t* __restrict__ Qb, const bf16_t* __restrict__ Kh, const bf16_t* __restrict__ Vh, bf16_t* __restrict__ Ob, int seq, LAS unsigned char* lds) {
  const int tid = threadIdx.x, wid = __builtin_amdgcn_readfirstlane(tid >> 6), lane = tid & 63, r32 = lane & 31, hi = lane >> 5;
  LAS float* ws = (LAS float*)(lds + WS_OFF) + wid * 64; LAS float* li_l = ws; LAS float* al_l = ws + 32;
  float m_reg = -1e30f, l_reg = 0; f32x16 o[4] = {}; bf16x8 qr[12];
  const bf16_t* Qw = Qb + (long)(wid * QBLK + r32) * LDQ + hi * 8;
#pragma unroll
  for (int d0 = 0; d0 < 12; ++d0) qr[d0] = *reinterpret_cast<const bf16x8*>(Qw + d0 * 16);
  unsigned voffK[3], voffV[2];
  { const int row = wid * 8 + (lane >> 3), f = (row >> 1) & 7, j = lane & 7;
#pragma unroll
    for (int i = 0; i < 3; ++i) voffK[i] = (unsigned)((row * LDK + (i * 8 + (j ^ f)) * 8) * 2);
#pragma unroll
    for (int i = 0; i < 2; ++i) { const int B = wid * 2 + i, st = 2 * B + (lane >> 5), kk = (st >> 2) * 8 + ((lane & 31) >> 2), c = (st & 3) * 32 + (lane & 3) * 8;
      const int k = (kk & ~0xC) | ((kk & 4) << 1) | ((kk & 8) >> 1); voffV[i] = (unsigned)((k * LDV + c) * 2); } }
  int kx[4];
  { const int f = (r32 >> 1) & 7, base0 = (r32 >> 3) * 3072 + (r32 & 7) * 128;
#pragma unroll
    for (int m = 0; m < 4; ++m) kx[m] = base0 + (((2 * m + hi) ^ f) << 4); }
  const int vb0 = (int)(uintptr_t)(lds + V_OFF) + v_rd_base(lane);
  const int NT = seq / KVBLK;
#define DMA_GROUP(t) do { const int tk_ = ((t) + 2 < NT) ? (t) + 2 : NT - 1, tv_ = ((t) + 1 < NT) ? (((t) + 1 < 0) ? 0 : (t) + 1) : NT - 1; const int sk_ = ((t) + 2) % 3, sv_ = ((t) + 4) % 3; \
    const char* kg_ = (const char*)Kh + (size_t)tk_ * (KVBLK * LDK * 2); const char* vg_ = (const char*)Vh + (size_t)tv_ * (KVBLK * LDV * 2); \
    _Pragma("unroll") for (int i_ = 0; i_ < 3; ++i_) __builtin_amdgcn_global_load_lds((const unsigned*)(kg_ + voffK[i_]), (LAS unsigned*)(lds + K_OFF + sk_ * KSLOT + (wid * 3 + i_) * 1024), 16, 0, 0); \
    _Pragma("unroll") for (int i_ = 0; i_ < 2; ++i_) __builtin_amdgcn_global_load_lds((const unsigned*)(vg_ + voffV[i_]), (LAS unsigned*)(lds + V_OFF + sv_ * VSLOT + (wid * 2 + i_) * 1024), 16, 0, 0); } while (0)
#define TILE_SYNC() do { asm volatile("s_waitcnt vmcnt(5)" ::: "memory"); __builtin_amdgcn_s_barrier(); asm volatile("" ::: "memory"); } while (0)
#define RESC(a) do { if (__any((a) < 1.f)) { if (hi == 0) al_l[r32] = (a); asm volatile("s_waitcnt lgkmcnt(0)" ::: "memory"); \
    _Pragma("unroll") for (int d = 0; d < 4; ++d) _Pragma("unroll") for (int r = 0; r < 16; ++r) o[d][r] *= al_l[crow(r, hi)]; } } while (0)
  f32x16 pA0, pA1, pB0, pB1; float mnA, mnB, alA, alB; bf16x8 pa0, pa1, pa2, pa3;
  asm volatile("s_waitcnt vmcnt(0)" ::: "memory");
  DMA_GROUP(-2); DMA_GROUP(-1);
  TILE_SYNC(); DMA_GROUP(0);
  qkt2(pA0, pA1, lds + K_OFF, kx, qr); partialSM(pA0, pA1, m_reg, mnA, alA);
  int ks = 1, vs = 0;
#define TILE_BODY0(PN0, PN1, MNN, ALN, PF0, PF1, ALF) do { \
    SBAR(); qkt2(PN0, PN1, lds + K_OFF + ks * KSLOT, kx, qr); finishSM(PF0, PF1, ALF, l_reg, pa0, pa1, pa2, pa3); SBAR(); \
    pv_d0(o, vb0 + vs * VSLOT, pa0, pa1, pa2, pa3); partialSM(PN0, PN1, m_reg, MNN, ALN); \
    RESC(ALN); ks = (ks == 2) ? 0 : ks + 1; vs = (vs == 2) ? 0 : vs + 1; } while (0)
#define TILE_BODY1(PN0, PN1, MNN, ALN, PF0, PF1, ALF) do { \
    SBAR(); finishSM(PF0, PF1, ALF, l_reg, pa0, pa1, pa2, pa3); SBAR(); qkt2(PN0, PN1, lds + K_OFF + ks * KSLOT, kx, qr); SBAR(); \
    partialSM(PN0, PN1, m_reg, MNN, ALN); SBAR(); pv_d0(o, vb0 + vs * VSLOT, pa0, pa1, pa2, pa3); SBAR(); \
    RESC(ALN); ks = (ks == 2) ? 0 : ks + 1; vs = (vs == 2) ? 0 : vs + 1; } while (0)
#define TILE_BODY(...) do { if constexpr (ORDER == 0) TILE_BODY0(__VA_ARGS__); else TILE_BODY1(__VA_ARGS__); } while (0)
  for (int j = 1; j + 1 < NT; j += 2) {
    TILE_SYNC(); DMA_GROUP(j);
    TILE_BODY(pB0, pB1, mnB, alB, pA0, pA1, alA);
    TILE_SYNC(); DMA_GROUP(j + 1);
    TILE_BODY(pA0, pA1, mnA, alA, pB0, pB1, alB);
  }
  TILE_SYNC(); DMA_GROUP(NT - 1);
  TILE_BODY(pB0, pB1, mnB, alB, pA0, pA1, alA);
#undef TILE_BODY
  finishSM(pB0, pB1, alB, l_reg, pa0, pa1, pa2, pa3); SBAR();
  TILE_SYNC();
  pv_d0(o, vb0 + vs * VSLOT, pa0, pa1, pa2, pa3);
#undef TILE_BODY0
#undef TILE_BODY1
  if (hi == 0) li_l[r32] = l_reg; asm volatile("s_waitcnt lgkmcnt(0)" ::: "memory");
  float rli[16];
#pragma unroll
  for (int r = 0; r < 16; ++r) rli[r] = __builtin_amdgcn_rcpf(li_l[crow(r, hi)]);
  bf16_t* Ow = Ob + (long)(wid * QBLK) * LDO;
#pragma unroll
  for (int r = 0; r < 16; ++r) { const int orow = crow(r, hi);
#pragma unroll
    for (int d0 = 0; d0 < 4; ++d0) Ow[(long)orow * LDO + d0 * 32 + r32] = (bf16_t)(cvt_pk_bf16(o[d0][r] * rli[r], 0.f) & 0xffffu); }
  asm volatile("s_waitcnt vmcnt(0) lgkmcnt(0)" ::: "memory"); __builtin_amdgcn_s_barrier(); asm volatile("" ::: "memory");
#undef DMA_GROUP
#undef TILE_SYNC
#undef RESC
}
__device__ __forceinline__ void attn_body4(const bf16_t* __restrict__ Qb, const bf16_t* __restrict__ Kh, const bf16_t* __restrict__ Vh, bf16_t* __restrict__ Ob, int seq, LAS unsigned char* lds) {
  if (__builtin_amdgcn_readfirstlane(threadIdx.x >> 6) < 4) attn_unit4<0>(Qb, Kh, Vh, Ob, seq, lds); else attn_unit4<1>(Qb, Kh, Vh, Ob, seq, lds);
}
}

namespace att8 {
using namespace att;
using namespace att2;
typedef int v4i __attribute__((ext_vector_type(4)));
typedef int v16i __attribute__((ext_vector_type(16)));
constexpr int K8SLOT = KVBLK * DQK, SSLOT = 1024, K8_OFF = 0, V8_OFF = 3 * K8SLOT, S8_OFF = V8_OFF + 3 * VSLOT, WS8_OFF = S8_OFF + 3 * SSLOT, SHM8 = WS8_OFF + NWAVES * 64 * 4;
static_assert(SHM8 <= RING_BYTES, "attention v8 LDS");
constexpr float MAGICF = 12582912.f; constexpr int MAGICI = 0x4B400000;
__device__ __forceinline__ void qkt8(f32x16& p0, f32x16& p1, float& t0, float& t1, LAS const unsigned char* kl  , LAS const unsigned char* sl  , const v4i (&qr)[6], const v16i& mg, float sq) {
  v16i a0, a1;
#pragma unroll
  for (int cp = 0; cp < 6; ++cp) {
    const v4i b0 = *(LAS const v4i*)(kl + (2 * cp) * 1024), b1 = *(LAS const v4i*)(kl + (2 * cp + 1) * 1024);
    a0 = __builtin_amdgcn_mfma_i32_32x32x32_i8(b0, qr[cp], cp ? a0 : mg, 0, 0, 0);
    a1 = __builtin_amdgcn_mfma_i32_32x32x32_i8(b1, qr[cp], cp ? a1 : mg, 0, 0, 0); }
  const f32x2 st = *(LAS const f32x2*)sl; t0 = st[0] * sq; t1 = st[1] * sq;
  p0 = __builtin_bit_cast(f32x16, a0); p1 = __builtin_bit_cast(f32x16, a1);
}
template <bool ZM>
__device__ __forceinline__ void partialSM8(f32x16& p0, f32x16& p1, float& m_reg, float& mn, float& alpha, float t0, float t1) {
  if constexpr (ZM) {
    const float u0 = MAGICF * t0, u1 = MAGICF * t1; mn = 0.f; alpha = 1.f;
#pragma unroll
    for (int r = 0; r < 16; ++r) p0[r] = __builtin_fmaf(p0[r], t0, -u0);
#pragma unroll
    for (int r = 0; r < 16; ++r) p1[r] = __builtin_fmaf(p1[r], t1, -u1);
#pragma unroll
    for (int r = 0; r < 16; ++r) p0[r] = __builtin_amdgcn_exp2f(p0[r]);
    return; }
  float f0 = p0[0], f1 = p1[0];
#pragma unroll
  for (int r = 1; r < 16; ++r) { f0 = fmaxf(f0, p0[r]); f1 = fmaxf(f1, p1[r]); }
  float pmax = fmaxf(__builtin_fmaf(f0, t0, -MAGICF * t0), __builtin_fmaf(f1, t1, -MAGICF * t1));
  { auto rr = __builtin_amdgcn_permlane32_swap(__float_as_uint(pmax), __float_as_uint(pmax), false, false);
    pmax = fmaxf(__uint_as_float(rr[0]), __uint_as_float(rr[1])); }
  if (__builtin_expect(__all(pmax - m_reg <= THR), 1)) { mn = m_reg; alpha = 1.f; }
  else { mn = fmaxf(m_reg, pmax); alpha = __builtin_amdgcn_exp2f(m_reg - mn); m_reg = mn; }
  const float u0 = __builtin_fmaf(MAGICF, t0, mn), u1 = __builtin_fmaf(MAGICF, t1, mn);
#pragma unroll
  for (int r = 0; r < 16; ++r) p0[r] = __builtin_fmaf(p0[r], t0, -u0);
#pragma unroll
  for (int r = 0; r < 16; ++r) p1[r] = __builtin_fmaf(p1[r], t1, -u1);
#pragma unroll
  for (int r = 0; r < 16; ++r) p0[r] = __builtin_amdgcn_exp2f(p0[r]);
}
template <int ORDER, bool ZM>
__device__ __forceinline__ bool attn_unit8(const bf16_t* __restrict__ Qbw  ,
                                            const signed char* __restrict__ K8h, const float* __restrict__ ksh, const bf16_t* __restrict__ Vh, bf16_t* __restrict__ Ob, int seq, LAS unsigned char* lds) {
  const int tid = threadIdx.x, wid = __builtin_amdgcn_readfirstlane(tid >> 6), lane = tid & 63, r32 = lane & 31, hi = lane >> 5;
  LAS float* ws = (LAS float*)(lds + WS8_OFF) + wid * 64; LAS float* li_l = ws; LAS float* al_l = ws + 32;
  float m_reg = -1e30f, l_reg = 0; f32x16 o[4] = {}; v4i qr[6];
  float sq;
  { const bf16_t* Qw = Qbw + (long)(wid * QBLK + r32) * LDQ + hi * 16; u32x4 raw[12]; float mx = 0.f;
#pragma unroll
    for (int cp = 0; cp < 6; ++cp) { raw[2 * cp] = *reinterpret_cast<const u32x4*>(Qw + cp * 32); raw[2 * cp + 1] = *reinterpret_cast<const u32x4*>(Qw + cp * 32 + 8); }
#pragma unroll
    for (int j = 0; j < 12; ++j)
#pragma unroll
      for (int e = 0; e < 4; ++e) mx = fmaxf(mx, fmaxf(fabsf(bflo(raw[j][e])), fabsf(bfhi(raw[j][e]))));
    { auto rr = __builtin_amdgcn_permlane32_swap(__float_as_uint(mx), __float_as_uint(mx), false, false); mx = fmaxf(__uint_as_float(rr[0]), __uint_as_float(rr[1])); }
    const float isc = mx > 0.f ? 127.f / mx : 0.f; sq = mx * (1.f / 127.f);
#pragma unroll
    for (int cp = 0; cp < 6; ++cp)
#pragma unroll
      for (int w = 0; w < 4; ++w) { const u32x4& a = raw[2 * cp + (w >> 1)]; const unsigned x0 = a[(w & 1) * 2], x1 = a[(w & 1) * 2 + 1];
        const int q0 = (int)__builtin_rintf(bflo(x0) * isc) & 0xff, q1 = (int)__builtin_rintf(bfhi(x0) * isc) & 0xff, q2 = (int)__builtin_rintf(bflo(x1) * isc) & 0xff, q3 = (int)__builtin_rintf(bfhi(x1) * isc) & 0xff;
        qr[cp][w] = q0 | (q1 << 8) | (q2 << 16) | (q3 << 24); } }
  constexpr int NKP = (ORDER == 0) ? 2 : 1;
  unsigned voffK[NKP], voffV[2]; int kpiece0;
  { kpiece0 = (ORDER == 0) ? 2 * wid : 8 + (wid - 4);
#pragma unroll
    for (int i = 0; i < NKP; ++i) { const int p = kpiece0 + i, cp = p >> 1, hf = p & 1; voffK[i] = (unsigned)((32 * hf + r32) * DQK + (2 * cp + hi) * 16); }
#pragma unroll
    for (int i = 0; i < 2; ++i) { const int B = wid * 2 + i, st = 2 * B + (lane >> 5), kk = (st >> 2) * 8 + ((lane & 31) >> 2), c = (st & 3) * 32 + (lane & 3) * 8;
      const int k = (kk & ~0xC) | ((kk & 4) << 1) | ((kk & 8) >> 1); voffV[i] = (unsigned)((k * LDV + c) * 2); } }
  LAS const unsigned char* kl0 = lds + K8_OFF + lane * 16; LAS const unsigned char* sl0 = lds + S8_OFF;
  v16i mg; { int m1 = MAGICI; asm volatile("" : "+v"(m1));
#pragma unroll
    for (int r = 0; r < 16; ++r) mg[r] = m1; asm volatile("" : "+v"(mg)); }
  const int vb0 = (int)(uintptr_t)(lds + V8_OFF) + v_rd_base(lane);
  const int NT = seq / KVBLK;
#define DMA_GROUP(t) do { const int tk_ = ((t) + 2 < NT) ? (t) + 2 : NT - 1, tv_ = ((t) + 1 < NT) ? (((t) + 1 < 0) ? 0 : (t) + 1) : NT - 1; const int sk_ = ((t) + 2) % 3, sv_ = ((t) + 4) % 3; \
    const char* kg_ = (const char*)K8h + (size_t)tk_ * (KVBLK * DQK); const char* vg_ = (const char*)Vh + (size_t)tv_ * (KVBLK * LDV * 2); \
    _Pragma("unroll") for (int i_ = 0; i_ < NKP; ++i_) __builtin_amdgcn_global_load_lds((const unsigned*)(kg_ + voffK[i_]), (LAS unsigned*)(lds + K8_OFF + sk_ * K8SLOT + (kpiece0 + i_) * 1024), 16, 0, 0); \
    if constexpr (ORDER == 1) __builtin_amdgcn_global_load_lds((const unsigned*)(ksh + (size_t)tk_ * 2 + (lane & 1)), (LAS unsigned*)(lds + S8_OFF + sk_ * SSLOT + (wid - 4) * 256), 4, 0, 0); \
    _Pragma("unroll") for (int i_ = 0; i_ < 2; ++i_) __builtin_amdgcn_global_load_lds((const unsigned*)(vg_ + voffV[i_]), (LAS unsigned*)(lds + V8_OFF + sv_ * VSLOT + (wid * 2 + i_) * 1024), 16, 0, 0); } while (0)
#define TILE_SYNC() do { asm volatile("s_waitcnt vmcnt(4)" ::: "memory"); __builtin_amdgcn_s_barrier(); asm volatile("" ::: "memory"); } while (0)
#define RESC(a) do { if (!ZM && __any((a) < 1.f)) { if (hi == 0) al_l[r32] = (a); asm volatile("s_waitcnt lgkmcnt(0)" ::: "memory"); \
    _Pragma("unroll") for (int d = 0; d < 4; ++d) _Pragma("unroll") for (int r = 0; r < 16; ++r) o[d][r] *= al_l[crow(r, hi)]; } } while (0)
  f32x16 pA0, pA1, pB0, pB1; float mnA, mnB, alA, alB, tA0, tA1, tB0, tB1; bf16x8 pa0, pa1, pa2, pa3;
  asm volatile("s_waitcnt vmcnt(0)" ::: "memory");
  DMA_GROUP(-2); DMA_GROUP(-1);
  TILE_SYNC(); DMA_GROUP(0);
  qkt8(pA0, pA1, tA0, tA1, kl0, sl0, qr, mg, sq); partialSM8<ZM>(pA0, pA1, m_reg, mnA, alA, tA0, tA1);
  int ks = 1, vs = 0;
#define TILE_BODY0(PN0, PN1, MNN, ALN, TN0, TN1, PF0, PF1, ALF) do { \
    SBAR(); qkt8(PN0, PN1, TN0, TN1, kl0 + ks * K8SLOT, sl0 + ks * SSLOT, qr, mg, sq); finishSM(PF0, PF1, ALF, l_reg, pa0, pa1, pa2, pa3); SBAR(); \
    pv_d0p(o, vb0 + vs * VSLOT, pa0, pa1, pa2, pa3); partialSM8<ZM>(PN0, PN1, m_reg, MNN, ALN, TN0, TN1); \
    RESC(ALN); ks = (ks == 2) ? 0 : ks + 1; vs = (vs == 2) ? 0 : vs + 1; } while (0)
#define TILE_BODY1(PN0, PN1, MNN, ALN, TN0, TN1, PF0, PF1, ALF) do { \
    SBAR(); finishSM(PF0, PF1, ALF, l_reg, pa0, pa1, pa2, pa3); SBAR(); qkt8(PN0, PN1, TN0, TN1, kl0 + ks * K8SLOT, sl0 + ks * SSLOT, qr, mg, sq); SBAR(); \
    partialSM8<ZM>(PN0, PN1, m_reg, MNN, ALN, TN0, TN1); SBAR(); pv_d0p(o, vb0 + vs * VSLOT, pa0, pa1, pa2, pa3); SBAR(); \
    RESC(ALN); ks = (ks == 2) ? 0 : ks + 1; vs = (vs == 2) ? 0 : vs + 1; } while (0)
#define TILE_BODY(...) do { if constexpr (ORDER == 0) TILE_BODY0(__VA_ARGS__); else TILE_BODY1(__VA_ARGS__); } while (0)
  for (int j = 1; j + 1 < NT; j += 2) {
    TILE_SYNC(); DMA_GROUP(j);
    TILE_BODY(pB0, pB1, mnB, alB, tB0, tB1, pA0, pA1, alA);
    TILE_SYNC(); DMA_GROUP(j + 1);
    TILE_BODY(pA0, pA1, mnA, alA, tA0, tA1, pB0, pB1, alB);
  }
  TILE_SYNC(); DMA_GROUP(NT - 1);
  TILE_BODY(pB0, pB1, mnB, alB, tB0, tB1, pA0, pA1, alA);
#undef TILE_BODY
  finishSM(pB0, pB1, alB, l_reg, pa0, pa1, pa2, pa3); SBAR();
  TILE_SYNC();
  pv_d0p(o, vb0 + vs * VSLOT, pa0, pa1, pa2, pa3);
#undef TILE_BODY0
#undef TILE_BODY1
  if (hi == 0) li_l[r32] = l_reg; asm volatile("s_waitcnt lgkmcnt(0)" ::: "memory");
  float rli[16];
#pragma unroll
  for (int r = 0; r < 16; ++r) rli[r] = __builtin_amdgcn_rcpf(li_l[crow(r, hi)]);
  bf16_t* Ow = Ob + (long)(wid * QBLK) * LDO;
#pragma unroll
  for (int r = 0; r < 16; ++r) { const int orow = crow(r, hi);
#pragma unroll
    for (int d0 = 0; d0 < 4; ++d0) Ow[(long)orow * LDO + d0 * 32 + r32] = (bf16_t)(cvt_pk_bf16(o[d0][r] * rli[r], 0.f) & 0xffffu); }
  bool redo = false;
  if constexpr (ZM) { const bool bad = !(l_reg > 1e-20f && l_reg < 1e20f);
    const int ab = __any(bad); if (lane == 0) ws[0] = ab ? 1.f : 0.f; }
  asm volatile("s_waitcnt vmcnt(0) lgkmcnt(0)" ::: "memory"); __builtin_amdgcn_s_barrier(); asm volatile("" ::: "memory");
  if constexpr (ZM) { float f = 0.f;
#pragma unroll
    for (int w = 0; w < NWAVES; ++w) f += ((LAS float*)(lds + WS8_OFF))[w * 64];
    redo = __builtin_amdgcn_readfirstlane(f > 0.f ? 1 : 0) != 0;
    __builtin_amdgcn_s_barrier(); }
#undef DMA_GROUP
#undef TILE_SYNC
#undef RESC
  return redo;
}
__device__ __forceinline__ void attn_body8(const bf16_t* __restrict__ Qbw, const signed char* __restrict__ K8h, const float* __restrict__ ksh, const bf16_t* __restrict__ Vh,
                                           bf16_t* __restrict__ Ob, int seq, LAS unsigned char* lds) {
  bool redo;
  if (__builtin_amdgcn_readfirstlane(threadIdx.x >> 6) < 4) redo = attn_unit8<0, true>(Qbw, K8h, ksh, Vh, Ob, seq, lds); else redo = attn_unit8<1, true>(Qbw, K8h, ksh, Vh, Ob, seq, lds);
  if (__builtin_expect(redo, 0)) {
    if (__builtin_amdgcn_readfirstlane(threadIdx.x >> 6) < 4) attn_unit8<0, false>(Qbw, K8h, ksh, Vh, Ob, seq, lds); else attn_unit8<1, false>(Qbw, K8h, ksh, Vh, Ob, seq, lds); }
}
}

struct Ctx {
    LAS unsigned char* lds; int tid, lane, wave, G, bid, gw, ngw;
};
template <int MODE>
__device__ __forceinline__ void transpose_item(const float* W, int K, int N, bf16_t* WT, float scale, const float* gk, LAS float* scr, int item, int lane) {
    const int nblk = N / 32, kb = item / nblk, nb = item % nblk, k0 = 64 * kb, n0 = 32 * nb;
#pragma unroll 8
    for (int i = 0; i < 32; ++i) { const int kk = 2 * i + (lane >> 5); scr[kk * 33 + (lane & 31)] = __builtin_nontemporal_load(&W[(size_t)(k0 + kk) * N + n0 + (lane & 31)]); }
    LDS_WAIT(); asm volatile("" ::: "memory");
    const int c = lane & 7;
#pragma unroll
    for (int j = 0; j < 4; ++j) { const int n = (lane >> 3) + 8 * j; const LAS float* s = scr + (8 * c) * 33 + n;
        int no = n0 + n;
        if (MODE == 1) { const int h = no / DQK, w = no % DQK; const int w2 = (w < DNOPE) ? w : ((w < DNOPE + 32) ? DNOPE + 2 * (w - DNOPE) : DNOPE + 2 * (w - DNOPE - 32) + 1); no = h * DQK + w2; }
        float sc8[8];
#pragma unroll
        for (int q = 0; q < 8; ++q) sc8[q] = (MODE == 2) ? gk[k0 + 8 * c + q] : ((MODE == 1 && gk) ? scale * gk[k0 + 8 * c + q] : scale);
        u32x4 o; o.x = cvt_pk_bf16(s[0 * 33] * sc8[0], s[1 * 33] * sc8[1]); o.y = cvt_pk_bf16(s[2 * 33] * sc8[2], s[3 * 33] * sc8[3]);
        o.z = cvt_pk_bf16(s[4 * 33] * sc8[4], s[5 * 33] * sc8[5]); o.w = cvt_pk_bf16(s[6 * 33] * sc8[6], s[7 * 33] * sc8[7]);
        *(u32x4*)(WT + (size_t)no * K + k0 + 8 * c) = o; }
    LDS_WAIT(); asm volatile("" ::: "memory");
}
__device__ __forceinline__ void transpose_item_i8(const float* W, int K, int N, signed char* WT8, const float* gk, const unsigned* cmax, LAS float* scr, int item, int lane, int* csum = nullptr) {
    const int nblk = N / 32, kb = item / nblk, nb = item % nblk, k0 = 64 * kb, n0 = 32 * nb;
#pragma unroll 8
    for (int i = 0; i < 32; ++i) { const int kk = 2 * i + (lane >> 5); scr[kk * 33 + (lane & 31)] = __builtin_nontemporal_load(&W[(size_t)(k0 + kk) * N + n0 + (lane & 31)]); }
    LDS_WAIT(); asm volatile("" ::: "memory");
    const int c = lane & 7; float g8[8];
#pragma unroll
    for (int q = 0; q < 8; ++q) g8[q] = gk ? gk[k0 + 8 * c + q] : 1.f;
#pragma unroll
    for (int j = 0; j < 4; ++j) { const int n = (lane >> 3) + 8 * j; const LAS float* s = scr + (8 * c) * 33 + n; const int no = n0 + n;
        const float cm = __uint_as_float(cmax[no]), isc = cm > 0.f ? 127.f / cm : 0.f; int qv[8];
        int sm = 0;
#pragma unroll
        for (int q = 0; q < 8; ++q) { const float t = __builtin_rintf(s[q * 33] * g8[q] * isc); const int qi = (int)fminf(fmaxf(t, -127.f), 127.f); sm += qi; qv[q] = qi & 0xff; }
        if (csum) { sm += __shfl_xor(sm, 1); sm += __shfl_xor(sm, 2); sm += __shfl_xor(sm, 4); if (c == 0) atomicAdd(csum + no, sm); }
        u32x2 o; o.x = (unsigned)(qv[0] | (qv[1] << 8) | (qv[2] << 16) | (qv[3] << 24)); o.y = (unsigned)(qv[4] | (qv[5] << 8) | (qv[6] << 16) | (qv[7] << 24));
        *(u32x2*)(WT8 + (size_t)no * K + k0 + 8 * c) = o; }
    LDS_WAIT(); asm volatile("" ::: "memory");
}
__device__ __forceinline__ void convert_transpose_i8(const Ctx& F, const float* W, int K, int N, signed char* WT8, const float* gk, const unsigned* cmax, int* csum = nullptr) {
    LAS float* scr = (LAS float*)(F.lds + F.wave * 8704);
    const int nitems = (K / 64) * (N / 32);
    for (int it = F.gw; it < nitems; it += F.ngw) transpose_item_i8(W, K, N, WT8, gk, cmax, scr, it, F.lane, csum);
}
__device__ __forceinline__ void col_absmax(const Ctx& F, const float* W, int K, int N, const float* gk, unsigned* cmax) {
    const int nstrip = N / 256, nitems = (K / 64) * nstrip;
    for (int it = F.gw; it < nitems; it += F.ngw) { const int kb = it / nstrip, nb = it % nstrip; const float* p = W + (size_t)(kb * 64) * N + nb * 256 + F.lane * 4; f32x4 m = {0.f, 0.f, 0.f, 0.f};
#pragma unroll 16
        for (int k = 0; k < 64; ++k) { const f32x4 v = __builtin_nontemporal_load((const f32x4*)(p + (size_t)k * N)); const float g = gk ? fabsf(gk[kb * 64 + k]) : 1.f;
            m[0] = fmaxf(m[0], fabsf(v[0]) * g); m[1] = fmaxf(m[1], fabsf(v[1]) * g); m[2] = fmaxf(m[2], fabsf(v[2]) * g); m[3] = fmaxf(m[3], fabsf(v[3]) * g); }
        unsigned* q = cmax + nb * 256 + F.lane * 4;
#pragma unroll
        for (int e = 0; e < 4; ++e) atomicMax(q + e, __float_as_uint(m[e])); }
}
template <int MODE>
__device__ __forceinline__ void convert_transpose(const Ctx& F, const float* W, int K, int N, bf16_t* WT, float scale, const float* gk = nullptr) {
    LAS float* scr = (LAS float*)(F.lds + F.wave * 8704);
    const int nitems = (K / 64) * (N / 32);
    for (int it = F.gw; it < nitems; it += F.ngw) transpose_item<MODE>(W, K, N, WT, scale, gk, scr, it, F.lane);
}
__device__ __forceinline__ void convert_plain(const Ctx& F, const float* W, bf16_t* O, size_t n8) {
    for (size_t i = (size_t)F.bid * NTHR + F.tid; i < n8; i += (size_t)F.G * NTHR) {
        const f32x4 a = __builtin_nontemporal_load((const f32x4*)(W + i * 8)), b = __builtin_nontemporal_load((const f32x4*)(W + i * 8 + 4));
        u32x4 o; o.x = cvt_pk_bf16(a[0], a[1]); o.y = cvt_pk_bf16(a[2], a[3]); o.z = cvt_pk_bf16(b[0], b[1]); o.w = cvt_pk_bf16(b[2], b[3]);
        *(u32x4*)(O + i * 8) = o; }
}
template <bool OUTF32>
__device__ __forceinline__ void rms_row4096(const float* xrow, const float* g, void* orow, int lane) {
    const f32x4* xr = (const f32x4*)xrow + lane; f32x4 v[16]; float s = 0.f;
#pragma unroll
    for (int j = 0; j < 16; ++j) { v[j] = __builtin_nontemporal_load(xr + 64 * j); s += (v[j][0] * v[j][0] + v[j][1] * v[j][1]) + (v[j][2] * v[j][2] + v[j][3] * v[j][3]); }
    const float rstd = rsqrtf(wave_sum(s) * (1.f / DM) + NORM_EPS);
    const f32x4* gr = (const f32x4*)g + lane;
#pragma unroll
    for (int j = 0; j < 16; ++j) { const f32x4 gv = gr[64 * j]; const f32x4 o = v[j] * rstd * gv;
        if (OUTF32) ((f32x4*)orow)[lane + 64 * j] = o;
        else { u32x2 w; w.x = cvt_pk_bf16(o[0], o[1]); w.y = cvt_pk_bf16(o[2], o[3]); ((u32x2*)orow)[lane + 64 * j] = w; } }
}
__device__ __forceinline__ void rms_rows(const Ctx& F, const float* X, const float* g, bf16_t* O, int rows) {
    for (int m = F.gw; m < rows; m += F.ngw) rms_row4096<false>(X + (size_t)m * DM, g, O + (size_t)m * DM, F.lane);
}
__device__ __forceinline__ void sincos_rev(double r, float& s, float& c) {
    const double q = __builtin_rint(r * 4.0); const double y = (r - q * 0.25) * 6.283185307179586476925;
    const double y2 = y * y;
    const double sp = y * (1.0 + y2 * (-1.0 / 6 + y2 * (1.0 / 120 + y2 * (-1.0 / 5040 + y2 * (1.0 / 362880 + y2 * (-1.0 / 39916800 + y2 * (1.0 / 6227020800.0)))))));
    const double cp = 1.0 + y2 * (-0.5 + y2 * (1.0 / 24 + y2 * (-1.0 / 720 + y2 * (1.0 / 40320 + y2 * (-1.0 / 3628800 + y2 * (1.0 / 479001600.0 + y2 * (-1.0 / 87178291200.0)))))));
    const int qi = ((int)q) & 3;
    const double ss = (qi == 0) ? sp : (qi == 1) ? cp : (qi == 2) ? -sp : -cp;
    const double cc = (qi == 0) ? cp : (qi == 1) ? -sp : (qi == 2) ? -cp : sp;
    s = (float)ss; c = (float)cc;
}
__constant__ float INV_FREQ[32] = {1.000000000e+00f, 7.498942018e-01f, 5.623413324e-01f, 4.216965139e-01f, 3.162277639e-01f, 2.371373773e-01f, 1.778279394e-01f, 1.333521456e-01f,
    1.000000015e-01f, 7.498942316e-02f, 5.623413250e-02f, 4.216964915e-02f, 3.162277490e-02f, 2.371373773e-02f, 1.778279431e-02f, 1.333521400e-02f,
    9.999999776e-03f, 7.498942316e-03f, 5.623413250e-03f, 4.216964822e-03f, 3.162277630e-03f, 2.371373819e-03f, 1.778279431e-03f, 1.333521446e-03f,
    1.000000047e-03f, 7.498941850e-04f, 5.623413017e-04f, 4.216965172e-04f, 3.162277571e-04f, 2.371373703e-04f, 1.778279402e-04f, 1.333521504e-04f};

struct Args { const void* in[23]; float* out; unsigned char* ws; int ph_lo, ph_hi; };
constexpr int N_PHASES = 15;

__global__ void __launch_bounds__(NTHR, 2) mk_fwd(Args args) {
    extern __shared__ __attribute__((aligned(16))) unsigned char lds_raw[];
    Ctx F; F.lds = (LAS unsigned char*)lds_raw; F.tid = threadIdx.x; F.lane = F.tid & 63; F.wave = __builtin_amdgcn_readfirstlane(F.tid >> 6);
    F.G = gridDim.x; F.bid = blockIdx.x; F.gw = F.bid * NWAVES + F.wave; F.ngw = F.G * NWAVES;
    volatile LAS unsigned* MISC = (volatile LAS unsigned*)(F.lds + MISC_OFF);
    unsigned char* ws = args.ws;
    unsigned* ctl = (unsigned*)(ws + WS_CTL);
#define INP(i) ((const float*)args.in[i])
#define in_x INP(0)
#define in_mem INP(1)
#define positions ((const int*)args.in[2])
#define g_mix INP(3)
#define w_in INP(4)
#define w_fourier INP(5)
#define g_q_lora INP(6)
#define w_uq INP(7)
#define g_kv_lora INP(8)
#define w_ukv INP(9)
#define g_fourier_out INP(10)
#define g_mla_out INP(11)
#define w_out INP(12)
#define g_xattn INP(13)
#define g_mem INP(14)
#define w_xq INP(15)
#define w_xk INP(16)
#define w_xv INP(17)
#define w_xo INP(18)
#define g_mlp INP(19)
#define w_ff1 INP(20)
#define w_ff2 INP(21)
#define g_final INP(22)
#define hbuf (args.out)
#define WSP(T, off) ((T*)(ws + (off)))
#define ropec WSP(float, WS_ROPEC)
#define ropes WSP(float, WS_ROPES)
#define y4096 WSP(float, WS_Y4096)
#define tr4096 WSP(float, WS_TR4096)
#define trQ WSP(float, WS_TR4096 + 16384)
#define tiQ WSP(float, WS_TR4096 + 32768)
#define Zf4 WSP(bf16_t, WS_ZE)
#define CD4 WSP(bf16_t, WS_CT)
#define ssq1 WSP(float, WS_SSQ1)
#define ssq2 WSP(float, WS_SSQ2)
#define ssqq WSP(float, WS_SSQQ)
#define ssqkv WSP(float, WS_SSQKV)
#define hrmax WSP(unsigned, WS_SSQQ)
#define w1cmax WSP(unsigned, WS_SSQKV)
#define hrsc WSP(float, WS_RSTDX)
#define A8 WSP(signed char, WS_YA)
#define ysc WSP(float, WS_RSTDX)
#define wocmax WSP(unsigned, 48 * 1024)
#define Y8 WSP(signed char, WS_Y)
#define WoutT8 WSP(signed char, WS_WOUTT)
#define W1T8 ((signed char*)args.out)
#define rstdx WSP(float, WS_RSTDX)
#define XB ((bf16_t*)args.out)
#define Ze WSP(bf16_t, WS_ZE)
#define Zo WSP(bf16_t, WS_ZO)
#define memn WSP(bf16_t, WS_MEMN)
#define KVx WSP(bf16_t, WS_KX)
#define WuqT WSP(bf16_t, WS_WUQT)
#define WukvT WSP(bf16_t, WS_WUKVT)
#define MgT WSP(bf16_t, WS_MGT)
#define MT WSP(bf16_t, WS_MT)
#define NVT WSP(bf16_t, WS_NVT)
#define XN WSP(bf16_t, WS_XN)
#define TT WSP(bf16_t, WS_TT)
#define Cs WSP(bf16_t, WS_CS)
#define Ss WSP(bf16_t, WS_SS)
#define Y WSP(bf16_t, WS_Y)
#define Abuf WSP(bf16_t, WS_A)
#define zf WSP(bf16_t, WS_ZF)
#define cq WSP(bf16_t, WS_CQ)
#define ckv WSP(bf16_t, WS_CKV)
#define krope WSP(bf16_t, WS_KROPE)
#define Ct WSP(bf16_t, WS_CT)
#define Dt WSP(bf16_t, WS_DT)
#define WinT WSP(bf16_t, WS_WINT)
#define WxkT WSP(bf16_t, WS_WXKT)
#define WxvT WSP(bf16_t, WS_WXVT)
#define Qb WSP(bf16_t, WS_Q)
#define Kb WSP(bf16_t, WS_K)
#define Vb WSP(bf16_t, WS_V)
#define yA WSP(bf16_t, WS_YA)
#define Q8 WSP(signed char, WS_WXQ)
#define K8 WSP(signed char, WS_K)
#define krr WSP(unsigned, WS_K + 50 * MiB)
#define krmax WSP(float, WS_K + 53 * MiB)
#define q8s WSP(float, WS_WXQ + 96 * MiB)
#define k8s WSP(float, WS_K + 48 * MiB)
#define SC WSP(float, WS_SC)
#define WoutT WSP(bf16_t, WS_WOUTT)
#define Pb8 WSP(unsigned char, WS_P)
#define MT8 WSP(unsigned char, WS_MT)
#define NVT8 WSP(unsigned char, WS_NVT)
#define H8 WSP(unsigned char, WS_CT)
#define Wxq WSP(bf16_t, WS_WXQ)
#define WxoT WSP(bf16_t, WS_WXOT)
#define W1T ((bf16_t*)args.out)
#define W2T ((bf16_t*)args.out + (size_t)DFF * DM)
#define W2T8 ((signed char*)args.out + (size_t)128 * MiB)
#define A2_8 WSP(signed char, WS_YA)
#define armax WSP(unsigned, 384 * 1024)
#define w2csum WSP(int, 448 * 1024)
#define w2cmax WSP(unsigned, 48 * 1024)
#define a2sc WSP(float, WS_RSTDX)

    if (F.tid < 64) MISC[F.tid] = 0u;
    __syncthreads();
#if !MK_PER_PHASE
    XcdBarrier bar = xcd_barrier_post(ctl + CW_BAR, MISC + 8);
#define GRID_BAR() xcd_barrier(bar)
#else
#define GRID_BAR() do {} while (0)
#endif
    const int lo = args.ph_lo, hi = args.ph_hi;
#ifndef PH_MASK
#define PH_MASK 0x7fff
#endif
#define IN(k) (((PH_MASK >> (k)) & 1) && lo <= (k) && (k) < hi)
#ifndef PROBE_TS
#define PROBE_TS 0
#endif
#define STAMP(k) do { if (PROBE_TS && F.bid == 0 && F.tid == 0) { ((unsigned long long*)(ctl + 8192))[k] = __builtin_amdgcn_s_memrealtime(); ((unsigned long long*)(ctl + 8192))[32 + (k)] = __builtin_amdgcn_s_memtime(); } } while (0)
#define SEAM(k) do { if (IN((k) + 1)) GRID_BAR(); STAMP((k) + 1); } while (0)
#ifndef REP_MASK
#define REP_MASK 0
#endif
#define REPS(k) for (int rep_ = 0; rep_ <= ((REP_MASK >> (k)) & 1); ++rep_)
    const int G = F.G, cid = F.bid;
    STAMP(0);

    if (IN(0)) {
REPS(0) {
        REPS(16) {
        for (int m = F.gw; m < NTOK; m += F.ngw) {
            const f32x4* xr = (const f32x4*)(in_x + (size_t)m * DM) + F.lane; f32x4 v[16]; float sx = 0.f;
#pragma unroll
            for (int j = 0; j < 16; ++j) { v[j] = __builtin_nontemporal_load(xr + 64 * j); sx += (v[j][0] * v[j][0] + v[j][1] * v[j][1]) + (v[j][2] * v[j][2] + v[j][3] * v[j][3]); }
            sx = wave_sum(sx); if (F.lane == 0) rstdx[m] = rsqrtf(sx * (1.f / DM) + NORM_EPS);
#pragma unroll
            for (int j = 0; j < 16; ++j) { u32x2 w; w.x = cvt_pk_bf16(v[j][0], v[j][1]); w.y = cvt_pk_bf16(v[j][2], v[j][3]); ((u32x2*)(XB + (size_t)m * DM))[F.lane + 64 * j] = w; } }
        rms_rows(F, in_mem, g_mem, memn, NB * MEMT);
        }
        REPS(17) {
        convert_transpose<2>(F, w_in, DM, INW, WinT, 1.f, g_mix);
        for (size_t i = (size_t)F.bid * NTHR + F.tid; i < (size_t)(INWP - INW) * DM / 8; i += (size_t)G * NTHR) *(u32x4*)(WinT + (size_t)INW * DM + i * 8) = (u32x4){0u, 0u, 0u, 0u};
        convert_transpose<0>(F, w_xk, DM, DM, WxkT, 1.f);
        convert_transpose<0>(F, w_xv, DM, DM, WxvT, 1.f);
        convert_transpose<1>(F, w_uq, QR, NH * DQK, WuqT, 0.10411754627697264f);
        convert_transpose<0>(F, w_ukv, KVR, NH * (DNOPE + DV), WukvT, 1.f);
        }
        REPS(18) {
        for (int i = F.bid * NTHR + F.tid; i < NTOK * 32; i += G * NTHR) { const int t = i >> 5, j = i & 31;
            const float ang = (float)positions[t] * INV_FREQ[j];
            double r = (double)ang * 0.15915494309189533577; r -= __builtin_floor(r);
            float s, c; sincos_rev(r, s, c); ropec[i] = c; ropes[i] = s; }
        }
        REPS(19) {
        for (int i = F.bid * NTHR + F.tid; i < 4 * (SEQ / 4) * (SEQ / 32); i += G * NTHR) { const int zz = i / ((SEQ / 4) * (SEQ / 32)), k = (i / (SEQ / 32)) % (SEQ / 4), s0 = (i % (SEQ / 32)) * 8;
            const int kk = 2 * k + (zz & 1); const float sh = (zz >= 2) ? 0.25f : 0.f; unsigned cw[4];
#pragma unroll
            for (int j = 0; j < 4; ++j) { const float f0 = (float)((kk * (s0 + 2 * j)) & (SEQ - 1)) * (1.f / SEQ) - sh, f1 = (float)((kk * (s0 + 2 * j + 1)) & (SEQ - 1)) * (1.f / SEQ) - sh;
                cw[j] = cvt_pk_bf16(__builtin_amdgcn_cosf(f0), __builtin_amdgcn_cosf(f1)); }
            *(u32x4*)(Cs + (size_t)i * 8) = (u32x4){cw[0], cw[1], cw[2], cw[3]}; }
        }
        REPS(20) {
        for (int task = F.gw; task < FG * FC; task += F.ngw) { const int g = task >> 8, c = task & 255;
            const float* wf = w_fourier + (size_t)g * FC * FC + F.lane; float ar[4] = {0.f, 0.f, 0.f, 0.f}, ai[4] = {0.f, 0.f, 0.f, 0.f};
#pragma unroll 8
            for (int l = 0; l < FC; ++l) { const float f = (float)((l * c) & 255) * (1.f / 256.f); const float cs = __builtin_amdgcn_cosf(f), sn = __builtin_amdgcn_sinf(f);
#pragma unroll
                for (int j = 0; j < 4; ++j) { const float w = wf[(size_t)l * FC + 64 * j]; ar[j] += cs * w; ai[j] -= sn * w; } }
#pragma unroll
            for (int j = 0; j < 4; ++j) { const int d = F.lane + 64 * j;
                MgT[((size_t)g * 512 + d) * FC + c] = (bf16_t)(cvt_pk_bf16(ar[j] * 0.0625f, 0.f) & 0xffffu); MgT[((size_t)g * 512 + 256 + d) * FC + c] = (bf16_t)(cvt_pk_bf16(ai[j] * 0.0625f, 0.f) & 0xffffu); } }
        }
        }
        SEAM(0);
    }
    if (IN(1)) {
REPS(1) {
        { pg8::Order S; S.init(XB, DM, WinT, DM, NTOK / 256, INWP / 256, 1, 1, 0, 0, 0, 0, G, cid);
          pg8::EpiInProj E{zf, cq, ckv, krope, rstdx, ssqq, ssqkv}; pg8::gemm_phase(F.lds, DM, DM, DM, S, E); }
        { const int sh = ((NTOK / 256) * (INWP / 256)) % G; pg8::Order S; S.init(memn, DM, WxkT, DM, (NB * MEMT) / 256, 2 * DM / 256, 1, 1, 0, 0, 0, 0, G, (cid - sh + G) % G);
          pg8::EpiBf16Lin<0> E{KVx, 2 * DM, 1, 0, 0, (size_t)256 * 2 * DM, 256, 1.f};
          pg8::gemm_phase(F.lds, DM, DM, DM, S, E); }
        }
        SEAM(1);
    }
    if (IN(2)) {
        for (int t = F.gw; t < NTOK; t += F.ngw) {
            { u32x4* p = (u32x4*)(cq + (size_t)t * QR) + F.lane; u32x4 a = p[0], b = p[64]; float s = 0.f;
#pragma unroll
              for (int j = 0; j < 4; ++j) { const float a0 = bflo(a[j]), a1 = bfhi(a[j]), b0 = bflo(b[j]), b1 = bfhi(b[j]); s += a0 * a0 + a1 * a1 + b0 * b0 + b1 * b1; }
              const float rstd = rsqrtf(wave_sum(s) * (1.f / QR) + NORM_EPS);
              const f32x4* gp = (const f32x4*)g_q_lora + F.lane * 2; const f32x4 g0 = gp[0], g1 = gp[1], g2 = gp[128], g3 = gp[129];
              u32x4 oa, ob;
              oa.x = cvt_pk_bf16(bflo(a.x) * rstd * g0[0], bfhi(a.x) * rstd * g0[1]); oa.y = cvt_pk_bf16(bflo(a.y) * rstd * g0[2], bfhi(a.y) * rstd * g0[3]);
              oa.z = cvt_pk_bf16(bflo(a.z) * rstd * g1[0], bfhi(a.z) * rstd * g1[1]); oa.w = cvt_pk_bf16(bflo(a.w) * rstd * g1[2], bfhi(a.w) * rstd * g1[3]);
              ob.x = cvt_pk_bf16(bflo(b.x) * rstd * g2[0], bfhi(b.x) * rstd * g2[1]); ob.y = cvt_pk_bf16(bflo(b.y) * rstd * g2[2], bfhi(b.y) * rstd * g2[3]);
              ob.z = cvt_pk_bf16(bflo(b.z) * rstd * g3[0], bfhi(b.z) * rstd * g3[1]); ob.w = cvt_pk_bf16(bflo(b.w) * rstd * g3[2], bfhi(b.w) * rstd * g3[3]);
              p[0] = oa; p[64] = ob; }
            { u32x4* p = (u32x4*)(ckv + (size_t)t * KVR) + F.lane; u32x4 a = p[0]; float s = 0.f;
#pragma unroll
              for (int j = 0; j < 4; ++j) { const float a0 = bflo(a[j]), a1 = bfhi(a[j]); s += a0 * a0 + a1 * a1; }
              const float rstd = rsqrtf(wave_sum(s) * (1.f / KVR) + NORM_EPS);
              const f32x4* gp = (const f32x4*)g_kv_lora + F.lane * 2; const f32x4 g0 = gp[0], g1 = gp[1];
              u32x4 oa;
              oa.x = cvt_pk_bf16(bflo(a.x) * rstd * g0[0], bfhi(a.x) * rstd * g0[1]); oa.y = cvt_pk_bf16(bflo(a.y) * rstd * g0[2], bfhi(a.y) * rstd * g0[3]);
              oa.z = cvt_pk_bf16(bflo(a.z) * rstd * g1[0], bfhi(a.z) * rstd * g1[1]); oa.w = cvt_pk_bf16(bflo(a.w) * rstd * g1[2], bfhi(a.w) * rstd * g1[3]);
              p[0] = oa; }
            if (F.lane < 32) { const int p = F.lane; const float t1 = bf2f(krope[(size_t)t * DROPE + p]), t2 = bf2f(krope[(size_t)t * DROPE + 32 + p]);
              const float c = ropec[(size_t)t * 32 + p], s = ropes[(size_t)t * 32 + p];
              const unsigned w = cvt_pk_bf16(t1 * c - t2 * s, t1 * s + t2 * c);
              krr[(size_t)t * 32 + p] = w; float mx = fmaxf(fabsf(bflo(w)), fabsf(bfhi(w)));
#pragma unroll
              for (int o = 16; o > 0; o >>= 1) mx = fmaxf(mx, __shfl_xor(mx, o));
              if (p == 0) krmax[t] = mx; }
        }
        for (int col = F.gw; col < NB * FW; col += F.ngw) {
            const int b = col / FW, g = (col % FW) / FC, d = col % FC;
            const bf16_t* zb = zf + (size_t)b * SEQ * FW + g * FC;
            const u32x2 zh = *((const u32x2*)(zb + (size_t)(SEQ / 2) * FW) + F.lane), zq = *((const u32x2*)(zb + (size_t)(SEQ / 4) * FW) + F.lane), z3 = *((const u32x2*)(zb + (size_t)(3 * SEQ / 4) * FW) + F.lane);
            const u32x2 mr = *((const u32x2*)(MgT + ((size_t)g * 512 + d) * FC) + F.lane), mi = *((const u32x2*)(MgT + ((size_t)g * 512 + 256 + d) * FC) + F.lane);
            float sh = bflo(zh.x) * bflo(mr.x) + bfhi(zh.x) * bfhi(mr.x) + bflo(zh.y) * bflo(mr.y) + bfhi(zh.y) * bfhi(mr.y);
            float sq = (bflo(zq.x) + bflo(z3.x)) * bflo(mr.x) + (bfhi(zq.x) + bfhi(z3.x)) * bfhi(mr.x) + (bflo(zq.y) + bflo(z3.y)) * bflo(mr.y) + (bfhi(zq.y) + bfhi(z3.y)) * bfhi(mr.y);
            float si = (bflo(zq.x) - bflo(z3.x)) * bflo(mi.x) + (bfhi(zq.x) - bfhi(z3.x)) * bfhi(mi.x) + (bflo(zq.y) - bflo(z3.y)) * bflo(mi.y) + (bfhi(zq.y) - bfhi(z3.y)) * bfhi(mi.y);
            sh = wave_sum(sh); sq = wave_sum(sq); si = wave_sum(si); if (F.lane == 0) { tr4096[col] = sh; trQ[col] = sq; tiQ[col] = si; } }
        for (int r = F.gw; r < NB * (SEQ / 4); r += F.ngw) { const int b = r / (SEQ / 4), sx = r % (SEQ / 4); const bf16_t* zb = zf + (size_t)b * SEQ * FW;
            const u32x4* p1 = (const u32x4*)(zb + (size_t)sx * FW) + F.lane; const u32x4* p2 = (const u32x4*)(zb + (size_t)(sx ? SEQ - sx : 0) * FW) + F.lane;
            const u32x4* p3 = (const u32x4*)(zb + (size_t)(SEQ / 2 - sx) * FW) + F.lane; const u32x4* p4 = (const u32x4*)(zb + (size_t)(SEQ / 2 + sx) * FW) + F.lane;
            const size_t arr = (size_t)NB * (SEQ / 4) * FW;
#pragma unroll
            for (int j = 0; j < 4; ++j) { const u32x4 w1 = __builtin_nontemporal_load(p1 + 64 * j), w2 = __builtin_nontemporal_load(p2 + 64 * j), w3 = __builtin_nontemporal_load(p3 + 64 * j), w4 = __builtin_nontemporal_load(p4 + 64 * j); u32x4 o0, o1, o2, o3;
#pragma unroll
                for (int q = 0; q < 4; ++q) { float x1l = bflo(w1[q]), x1h = bfhi(w1[q]), x2l = bflo(w2[q]), x2h = bfhi(w2[q]), x3l = bflo(w3[q]), x3h = bfhi(w3[q]), x4l = bflo(w4[q]), x4h = bfhi(w4[q]);
                    if (sx == 0) { x2l = 0.f; x2h = 0.f; x3l = 0.f; x3h = 0.f; x4l = 0.f; x4h = 0.f; }
                    const float al = x1l + x2l, ah = x1h + x2h, bl = x3l + x4l, bh = x3h + x4h, cl = x1l - x2l, ch = x1h - x2h, dl = x3l - x4l, dh = x3h - x4h;
                    o0[q] = cvt_pk_bf16(al + bl, ah + bh); o1[q] = cvt_pk_bf16(al - bl, ah - bh);
                    o2[q] = (sx == 0) ? 0u : cvt_pk_bf16(cl - dl, ch - dh); o3[q] = (sx == 0) ? 0u : cvt_pk_bf16(cl + dl, ch + dh); }
                u32x4* po = (u32x4*)(Zf4 + (size_t)r * FW) + F.lane + 64 * j;
                po[0] = o0; *(u32x4*)((bf16_t*)po + arr) = o1; *(u32x4*)((bf16_t*)po + 2 * arr) = o2; *(u32x4*)((bf16_t*)po + 3 * arr) = o3; } }
        convert_plain(F, w_xq, Wxq, (size_t)DM * DM / 8);
        convert_transpose<0>(F, w_xo, DM, DM, WxoT, 1.f);
        convert_transpose<0>(F, w_out, DM, DM, WoutT, 1.f);
        SEAM(2);
    }
    if (IN(3)) {
REPS(3) {
#ifndef P3M
#define P3M 31
#endif
        if (P3M & 1) {
#pragma unroll
          for (int e = 0; e < 2; ++e) { const size_t arr = (size_t)NB * (SEQ / 4) * FW;
            pg8::Order S; S.init(MgT, FC, Zf4 + e * arr, FW, 2, (SEQ / 4) / 256, NB, FG, 0, (size_t)512 * FC * 2, (size_t)(SEQ / 4) * FW * 2, (size_t)FC * 2, G, cid); S.pmB = 2 * arr * 2;
            pg8::EpiBf16Lin<0> E{TT + e * (SEQ / 4), SEQ, 1, (size_t)256 * SEQ, 0, (size_t)(SEQ / 2), 256, 1.f}; pg8::gemm_phase(F.lds, FC, FC, FW, S, E); } }
        if (P3M & 2) { pg8::Order S; S.init(cq, QR, WuqT, QR, NTOK / 256, (NH * DQK) / 256, 1, 1, 0, 0, 0, 0, G, cid);
          pg8::EpiQ E{Qb, ropec, ropes, ssqq}; pg8::gemm_phase(F.lds, QR, QR, QR, S, E); }
        if (P3M & 4) { pg8::Order S; S.init(ckv, KVR, WukvT, KVR, NTOK / 256, NH, 1, 1, 0, 0, 0, 0, G, cid);
          pg8::EpiKV8 E{K8, k8s, Vb, krr, krmax, (LAS float*)(F.lds + MISC_OFF + 1024)}; pg8::gemm_phase(F.lds, KVR, KVR, KVR, S, E); }
        if (P3M & 8) {
          pg8::Order S; S.init(KVx, 2 * DM, Wxq, DM, 1, DM / 256, NB, XH, (size_t)MEMT * 2 * DM * 2, (size_t)XHD * 2, 0, (size_t)XHD * 2, G, cid);
          pg8::EpiF8ColGain E{MT8, g_xattn, DM, XH, (size_t)XH * MEMT * DM, (size_t)MEMT * DM, 0, 256}; pg8::gemm_phase(F.lds, XHD, 2 * DM, DM, S, E); }
        if (P3M & 16) {
          const int sh = (NB * XH * (DM / 256)) % G; pg8::Order S; S.init(WxoT, DM, KVx + DM, 2 * DM, DM / 256, 1, NB, XH, 0, (size_t)XHD * 2, (size_t)MEMT * 2 * DM * 2, (size_t)XHD * 2, G, (cid - sh + G) % G);
          pg8::EpiF8Lin E{NVT8, XH * MEMT, XH, (size_t)DM * XH * MEMT, (size_t)MEMT, (size_t)256 * XH * MEMT, 0}; pg8::gemm_phase(F.lds, XHD, DM, 2 * DM, S, E); }
        }
        SEAM(3);
    }
    if (IN(4)) {
REPS(4) {
        for (int i = 0;; ++i) { const int L = i * G + cid; if (L >= NB * NH * (SEQ / 256)) break;
            int bh, qb; if (G == 256) { bh = i * 8 + (cid & 7); qb = cid >> 3; } else { bh = L / (SEQ / 256); qb = L % (SEQ / 256); }
            const int b = bh / NH, h = bh % NH; const size_t t0 = (size_t)b * SEQ;
            att8::attn_body8(Qb + (t0 + (size_t)qb * 256) * (NH * DQK) + h * DQK, K8 + (size_t)bh * SEQ * DQK, k8s + (size_t)bh * (SEQ / 32), Vb + t0 * (NH * DV) + h * DV,
                           yA + (t0 + (size_t)qb * 256) * FW + h * DV, SEQ, F.lds); }
        }
STAMP(20);
REPS(15) {
        {
          pg8::Order S; S.init(Cs, SEQ / 4, TT, SEQ, (SEQ / 4) / 256, (NB * FW) / 256, 4, 1, (size_t)(SEQ / 4) * (SEQ / 4) * 2, 0, (size_t)(SEQ / 4) * 2, 0, G, cid);
          pg8::EpiBf16Lin<0> E{CD4, NB * FW, 1, (size_t)(SEQ / 4) * NB * FW, 0, (size_t)256 * NB * FW, 256, 1.f}; pg8::gemm_phase(F.lds, SEQ / 4, SEQ / 4, SEQ, S, E); }
        }
        for (int col = F.gw; col < NB * FW; col += F.ngw) {
            const u32x4* p = (const u32x4*)(TT + (size_t)col * SEQ) + F.lane; float sa = 0.f;
#pragma unroll 4
            for (int j = 0; j < SEQ / 2048; ++j) { const u32x4 v = p[64 * j];
#pragma unroll
                for (int q = 0; q < 4; ++q) sa += bflo(v[q]) - bfhi(v[q]); }
            sa = wave_sum(sa); if (F.lane == 0) y4096[col] = sa + trQ[col] + tr4096[col]; }
        SEAM(4);
    }
    if (IN(5)) {
REPS(5) {
        const float isq = 0.011048543456039804f;
        for (int t = F.gw; t < NTOK; t += F.ngw) { const int b = t / SEQ, s = t % SEQ; const int k = (s <= SEQ / 2) ? s : SEQ - s; const float sg = (s <= SEQ / 2) ? 1.f : -1.f;
            f32x4 v[8]; float ss = 0.f;
#pragma unroll
            for (int j = 0; j < 4; ++j) { const int col = F.lane * 8 + 512 * j;
                if (s == SEQ / 2) { v[2 * j] = *(const f32x4*)(y4096 + b * FW + col) * isq; v[2 * j + 1] = *(const f32x4*)(y4096 + b * FW + col + 4) * isq; }
                else { const int k2 = k >> 1, odd = k & 1; const size_t zs = (size_t)(SEQ / 4) * NB * FW; const size_t ro = (size_t)k2 * (NB * FW) + b * FW + col;
                    const u32x4 c = *(const u32x4*)(CD4 + (odd ? zs : 0) + ro), d = *(const u32x4*)(CD4 + (odd ? 3 * zs : 2 * zs) + ro);
                    const float pk2 = (k2 & 1) ? -1.f : 1.f, pkh = odd ? -1.f : 1.f;
                    const float* rq = odd ? tiQ : trQ;
                    const f32x4 q0 = *(const f32x4*)(rq + b * FW + col) * pk2, q1 = *(const f32x4*)(rq + b * FW + col + 4) * pk2;
                    const f32x4 t0 = *(const f32x4*)(tr4096 + b * FW + col) * pkh, t1 = *(const f32x4*)(tr4096 + b * FW + col + 4) * pkh;
                    f32x4 c0 = (f32x4){bflo(c.x), bfhi(c.x), bflo(c.y), bfhi(c.y)}, c1 = (f32x4){bflo(c.z), bfhi(c.z), bflo(c.w), bfhi(c.w)};
                    f32x4 d0 = (f32x4){bflo(d.x), bfhi(d.x), bflo(d.y), bfhi(d.y)}, d1 = (f32x4){bflo(d.z), bfhi(d.z), bflo(d.w), bfhi(d.w)};
                    if (odd) { d0 += q0; d1 += q1; } else { c0 += q0; c1 += q1; }
                    v[2 * j] = (c0 + t0 + d0 * sg) * isq; v[2 * j + 1] = (c1 + t1 + d1 * sg) * isq; }
#pragma unroll
                for (int q = 0; q < 2; ++q) { const f32x4 w = v[2 * j + q]; ss += (w[0] * w[0] + w[1] * w[1]) + (w[2] * w[2] + w[3] * w[3]); } }
            const float rstd = rsqrtf(wave_sum(ss) * (1.f / FW) + NORM_EPS); float mx = 0.f;
#pragma unroll
            for (int j = 0; j < 4; ++j) { const int col = F.lane * 8 + 512 * j; const f32x4 g0 = *(const f32x4*)(g_fourier_out + col), g1 = *(const f32x4*)(g_fourier_out + col + 4);
                v[2 * j] = v[2 * j] * rstd * g0; v[2 * j + 1] = v[2 * j + 1] * rstd * g1;
#pragma unroll
                for (int q = 0; q < 2; ++q) { const f32x4 w = v[2 * j + q]; mx = fmaxf(mx, fmaxf(fmaxf(fabsf(w[0]), fabsf(w[1])), fmaxf(fabsf(w[2]), fabsf(w[3])))); } }
            u32x4 a[4]; float sa = 0.f;
#pragma unroll
            for (int j = 0; j < 4; ++j) { a[j] = __builtin_nontemporal_load((const u32x4*)(yA + (size_t)t * FW + F.lane * 8 + 512 * j));
#pragma unroll
                for (int q = 0; q < 4; ++q) { const float x0 = bflo(a[j][q]), x1 = bfhi(a[j][q]); sa += x0 * x0 + x1 * x1; } }
            const float rsa = rsqrtf(wave_sum(sa) * (1.f / FW) + NORM_EPS);
            f32x4 ya[8];
#pragma unroll
            for (int j = 0; j < 4; ++j) { const int col = F.lane * 8 + 512 * j; const f32x4 g0 = *(const f32x4*)(g_mla_out + col), g1 = *(const f32x4*)(g_mla_out + col + 4);
                ya[2 * j] = (f32x4){bflo(a[j].x), bfhi(a[j].x), bflo(a[j].y), bfhi(a[j].y)} * rsa * g0; ya[2 * j + 1] = (f32x4){bflo(a[j].z), bfhi(a[j].z), bflo(a[j].w), bfhi(a[j].w)} * rsa * g1;
#pragma unroll
                for (int q = 0; q < 2; ++q) { const f32x4 w = ya[2 * j + q]; mx = fmaxf(mx, fmaxf(fmaxf(fabsf(w[0]), fabsf(w[1])), fmaxf(fabsf(w[2]), fabsf(w[3])))); } }
#pragma unroll
            for (int j = 0; j < 4; ++j) { const int col = F.lane * 8 + 512 * j;
#pragma unroll
                for (int hf = 0; hf < 2; ++hf) { const f32x4 p0 = hf ? ya[2 * j] : v[2 * j], p1 = hf ? ya[2 * j + 1] : v[2 * j + 1];
                    u32x4 w; w.x = cvt_pk_bf16(p0[0], p0[1]); w.y = cvt_pk_bf16(p0[2], p0[3]); w.z = cvt_pk_bf16(p1[0], p1[1]); w.w = cvt_pk_bf16(p1[2], p1[3]);
                    *(u32x4*)(Y + (size_t)t * DM + hf * FW + col) = w; } }
        }
        }
        SEAM(5);
    }
    if (IN(6)) {
REPS(6) {
        pg8::Order S; S.init(Y, DM, WoutT, DM, NTOK / 256, DM / 256, 1, 1, 0, 0, 0, 0, G, cid);
        pg8::EpiResB<false, true> E{XB, XN, ssq1, DM, 0, H8, nullptr, nullptr, nullptr, nullptr, 1.f}; pg8::gemm_phase(F.lds, DM, DM, DM, S, E);
        }
        SEAM(6);
    }
    if (IN(8)) {
REPS(8) {
        pg8::Order S; S.init(H8, DM / 2, MT8, DM / 2, SEQ / 256, (XH * MEMT) / 256, NB, 1, (size_t)SEQ * DM, 0, (size_t)XH * MEMT * DM, 0, G, cid);
        pg8::EpiSoftmax E{Pb8, ssq1, XH * MEMT, 0.03125f, SEQ, (LAS float*)(F.lds + MISC_OFF + 1024)}; pg8::gemm_phase<true>(F.lds, DM / 2, DM / 2, DM / 2, S, E);
        }
        col_absmax(F, w_ff2, DFF, DM, nullptr, w2cmax);
        col_absmax(F, w_ff1, DM, DFF, g_mlp, w1cmax);
        SEAM(8);
    }
    if (IN(10)) {
        pg8::Order S; S.init(Pb8, (XH * MEMT) / 2, NVT8, (XH * MEMT) / 2, SEQ / 256, DM / 256, NB, 1, (size_t)SEQ * XH * MEMT, 0, (size_t)DM * XH * MEMT, 0, G, cid);
        pg8::EpiResB<false, false> E{XN, XN, nullptr, DM, SEQ, nullptr, nullptr, nullptr, nullptr, nullptr, 1.f / 256.f}; pg8::gemm_phase<true>(F.lds, (XH * MEMT) / 2, (XH * MEMT) / 2, (XH * MEMT) / 2, S, E);
        convert_transpose_i8(F, w_ff1, DM, DFF, W1T8, g_mlp, w1cmax);
        convert_transpose_i8(F, w_ff2, DFF, DM, W2T8, nullptr, w2cmax, w2csum);
        SEAM(10);
    }
    if (IN(11)) {
        for (int m = F.gw; m < NTOK; m += F.ngw) {
            const u32x4* hr = (const u32x4*)(XN + (size_t)m * DM) + F.lane; u32x4 v[8]; float rm = 0.f, ss = 0.f;
#pragma unroll
            for (int j = 0; j < 8; ++j) { v[j] = hr[64 * j];
#pragma unroll
                for (int e = 0; e < 4; ++e) { const float a = bflo(v[j][e]), b = bfhi(v[j][e]); rm = fmaxf(rm, fmaxf(fabsf(a), fabsf(b))); ss += a * a + b * b; } }
            ss = wave_sum(ss);
#pragma unroll
            for (int o = 32; o > 0; o >>= 1) rm = fmaxf(rm, __shfl_xor(rm, o));
            const float isc = rm > 0.f ? 127.f / rm : 0.f;
            if (F.lane == 0) hrsc[m] = rm * (1.f / 127.f) * rsqrtf(ss * (1.f / DM) + NORM_EPS);
#pragma unroll
            for (int j = 0; j < 8; ++j) { int q[8];
#pragma unroll
                for (int e = 0; e < 4; ++e) { q[2 * e] = (int)__builtin_rintf(bflo(v[j][e]) * isc) & 0xff; q[2 * e + 1] = (int)__builtin_rintf(bfhi(v[j][e]) * isc) & 0xff; }
                u32x2 o; o.x = (unsigned)(q[0] | (q[1] << 8) | (q[2] << 16) | (q[3] << 24)); o.y = (unsigned)(q[4] | (q[5] << 8) | (q[6] << 16) | (q[7] << 24));
                ((u32x2*)(A8 + (size_t)m * DM))[F.lane + 64 * j] = o; } }
        SEAM(11);
    }
    if (IN(12)) {
#if (REP_MASK >> 21) & 1
        {
            pg8::Order S; S.init(XN, DM, W1T, DM, NTOK / 256, DFF / 256, 1, 1, 0, 0, 0, 0, G, cid); S.tA = 0; S.tB = 0;
            pg8::EpiBf16Lin<1> E{(bf16_t*)(ws + WS_END) + (size_t)cid * 65536, 256, 1, 0, 0, 0, 0, 1.f}; pg8::gemm_phase(F.lds, DM, DM, DM, S, E); }
#endif
REPS(12) {
        pg8::Order S; S.init(A8, DM / 2, W1T8, DM / 2, NTOK / 256, DFF / 256, 1, 1, 0, 0, 0, 0, G, cid);
        pg8::EpiFFN1 E{Abuf, hrsc, (const float*)w1cmax, armax, DFF}; pg8::gemm_phase<2>(F.lds, DM / 2, DM / 2, DM / 2, S, E);
        }
        SEAM(12);
    }
    if (IN(13)) {
#if (REP_MASK >> 22) & 1
        {
            pg8::Order S; S.init(Abuf, DFF, W2T, DFF, NTOK / 256, DM / 256, 1, 1, 0, 0, 0, 0, G, cid);
            pg8::EpiBf16Lin<0> E{(bf16_t*)(ws + WS_END) + (size_t)cid * 65536, 256, 1, 0, 0, 0, 0, 1.f}; pg8::gemm_phase(F.lds, DFF, DFF, DFF, S, E); }
#endif
        for (int t = F.gw; t < NTOK; t += F.ngw) {
            const u32x4* src = (const u32x4*)(Abuf + (size_t)t * DFF) + F.lane; u32x2* dst = (u32x2*)(A2_8 + (size_t)t * DFF) + F.lane; constexpr int NALL = DFF / 512, NH2 = (NALL * 3) / 4; u32x4 v[NH2]; float am = 0.f;
#pragma unroll
            for (int i = 0; i < NH2; ++i) v[i] = src[64 * i];
#pragma unroll 8
            for (int i = NH2; i < NALL; ++i) { const u32x4 w = src[64 * i];
#pragma unroll
                for (int e = 0; e < 4; ++e) am = fmaxf(am, fmaxf(bflo(w[e]), bfhi(w[e]))); }
#pragma unroll
            for (int i = 0; i < NH2; ++i)
#pragma unroll
                for (int e = 0; e < 4; ++e) am = fmaxf(am, fmaxf(bflo(v[i][e]), bfhi(v[i][e])));
#pragma unroll
            for (int o = 32; o > 0; o >>= 1) am = fmaxf(am, __shfl_xor(am, o));
            const float isc = am > 0.f ? 255.f / am : 0.f; if (F.lane == 0) a2sc[t] = am * (1.f / 255.f);
#define A8CODES(W, I) do { int q[8]; _Pragma("unroll") for (int e = 0; e < 4; ++e) { q[2 * e] = ((int)__builtin_rintf(bflo(W[e]) * isc) - 128) & 0xff; q[2 * e + 1] = ((int)__builtin_rintf(bfhi(W[e]) * isc) - 128) & 0xff; } \
                u32x2 o; o.x = (unsigned)(q[0] | (q[1] << 8) | (q[2] << 16) | (q[3] << 24)); o.y = (unsigned)(q[4] | (q[5] << 8) | (q[6] << 16) | (q[7] << 24)); dst[64 * (I)] = o; } while (0)
#pragma unroll
            for (int i = 0; i < NH2; ++i) A8CODES(v[i], i);
#pragma unroll 8
            for (int i = NH2; i < NALL; ++i) { const u32x4 w = __builtin_nontemporal_load(src + 64 * i); A8CODES(w, i); }
#undef A8CODES
        }
        GRID_BAR();
        pg8::Order S; S.init(A2_8, DFF / 2, W2T8, DFF / 2, NTOK / 256, DM / 256, 1, 1, 0, 0, 0, 0, G, cid);
        pg8::EpiResB<false, false> E{XN, XN, nullptr, DM, 0, nullptr, nullptr, a2sc, (const float*)w2cmax, w2csum, 1.f}; pg8::gemm_phase<2>(F.lds, DFF / 2, DFF / 2, DFF / 2, S, E);
        SEAM(13);
    }
    if (IN(14)) {
        for (int m = F.gw; m < NTOK; m += F.ngw) {
            const u32x4* hr = (const u32x4*)(XN + (size_t)m * DM) + F.lane; u32x4 v[8]; float ss = 0.f;
#pragma unroll
            for (int j = 0; j < 8; ++j) { v[j] = __builtin_nontemporal_load(hr + 64 * j);
#pragma unroll
                for (int q = 0; q < 4; ++q) { const float a = bflo(v[j][q]), b = bfhi(v[j][q]); ss += a * a + b * b; } }
            const float rstd = rsqrtf(wave_sum(ss) * (1.f / DM) + NORM_EPS);
#pragma unroll
            for (int j = 0; j < 8; ++j) { const int col = (F.lane + 64 * j) * 8; const f32x4 g0 = *(const f32x4*)(g_final + col), g1 = *(const f32x4*)(g_final + col + 4);
                f32x4 o0 = (f32x4){bflo(v[j].x), bfhi(v[j].x), bflo(v[j].y), bfhi(v[j].y)} * rstd * g0, o1 = (f32x4){bflo(v[j].z), bfhi(v[j].z), bflo(v[j].w), bfhi(v[j].w)} * rstd * g1;
                *(f32x4*)(hbuf + (size_t)m * DM + col) = o0; *(f32x4*)(hbuf + (size_t)m * DM + col + 4) = o1; } }
    }
#if PROBE_TS
    STAMP(15);
    if (F.bid == 0) { VM_WAIT(); __syncthreads();
        const unsigned long long* ts = (const unsigned long long*)(ctl + 8192);
#if defined(PROBE_CLK)
        const float V = __builtin_floorf((float)(long long)(ts[32 + PROBE_A1] - ts[32 + PROBE_A0]) / (float)(long long)(ts[PROBE_A1] - ts[PROBE_A0]) * 0.5f + 0.5f);
#else
        const float V = __builtin_floorf((float)(long long)(ts[PROBE_A1] - ts[PROBE_A0]) * 0.01f / (float)PROBE_BIN + 0.5f);
#endif
        for (int i = F.tid; i < 4096; i += NTHR) hbuf[DM + i] = V; }
#endif
#undef IN
#undef SEAM
#undef GRID_BAR
}


extern "C" void kernel_launch(void* const* d_in, const int* in_sizes, int n_in, void* d_out, int out_size, void* d_ws, size_t ws_size, hipStream_t stream) {
    static int grid = 0;
    if (grid == 0) {
        if (n_in != 23 || in_sizes[0] != NTOK * DM || out_size != NTOK * DM || ws_size < WS_END) {
            fprintf(stderr, "kernel_launch: shape/workspace mismatch: n_in %d in0 %d out %d ws %zu (need >= %zu)\n", n_in, n_in > 0 ? in_sizes[0] : -1, out_size, ws_size, (size_t)WS_END); grid = -1; return; }
        int dev = 0, cus = 0, per_cu = 0;
        if (hipGetDevice(&dev) != hipSuccess || hipDeviceGetAttribute(&cus, hipDeviceAttributeMultiprocessorCount, dev) != hipSuccess) { fprintf(stderr, "kernel_launch: device query failed\n"); grid = -1; return; }
        if (hipFuncSetAttribute((const void*)mk_fwd, hipFuncAttributeMaxDynamicSharedMemorySize, LDS_BYTES) != hipSuccess) { fprintf(stderr, "kernel_launch: hipFuncSetAttribute failed\n"); grid = -1; return; }
        if (hipOccupancyMaxActiveBlocksPerMultiprocessor(&per_cu, (const void*)mk_fwd, NTHR, LDS_BYTES) != hipSuccess || per_cu < 1) {
            fprintf(stderr, "kernel_launch: occupancy query reports %d workgroups per CU\n", per_cu); }
        (void)hipGetLastError();
        grid = cus;
    }
    if (grid < 0) return;
    if (hipMemsetAsync((char*)d_ws + WS_CTL, 0, CTL_ZERO_BYTES, stream) != hipSuccess) { fprintf(stderr, "kernel_launch: memset failed\n"); return; }
    Args a{};
    for (int i = 0; i < 23; ++i) a.in[i] = d_in[i];
    a.out = (float*)d_out; a.ws = (unsigned char*)d_ws;
#if MK_PER_PHASE
#ifndef DBG_STOP
#define DBG_STOP N_PHASES
#endif
    for (int p = 0; p < DBG_STOP; ++p) { a.ph_lo = p; a.ph_hi = p + 1; hipLaunchKernelGGL(mk_fwd, dim3(grid), dim3(NTHR), LDS_BYTES, stream, a); }
#else
    a.ph_lo = 0; a.ph_hi = N_PHASES; hipLaunchKernelGGL(mk_fwd, dim3(grid), dim3(NTHR), LDS_BYTES, stream, a);
#endif
    const hipError_t le = hipPeekAtLastError();
    if (le != hipSuccess) fprintf(stderr, "kernel_launch: launch failed: %s\n", hipGetErrorName(le));
}
```
